# Optimizing an MI355X kernel written in HIP

```python
import math
import jax, jax.numpy as jnp
from jax import lax
import numpy as np

D_MODEL = 1024
BATCH = 8
SEQ = 2048
DEPTH = 4


f32 = jnp.float32

GRID_W = 64
CTX_LEN = 256
D_MIX = D_MODEL
POOL_WIDTH = D_MIX // 4
POOL_WINDOWS = (2, 4, 8, 16)
POOL_GROUP = POOL_WIDTH // len(POOL_WINDOWS)
SSM_WIDTH = D_MIX // 4
SSM_GROUP_CH = 16
SSM_GROUPS = SSM_WIDTH // SSM_GROUP_CH
SSM_STATE = 64
ATTN_WIDTH = D_MIX - POOL_WIDTH - SSM_WIDTH
HEAD_DIM = 64
N_HEADS = ATTN_WIDTH // HEAD_DIM
N_KV_HEADS = 2
GROUP = N_HEADS // N_KV_HEADS
KV_WIDTH = N_KV_HEADS * HEAD_DIM
WINDOW = 128
BLOCK = 128
ROPE_BASE = 10000.0
ROPE_FREQS = HEAD_DIM // 4
IN_SPLITS = (POOL_WIDTH, POOL_WIDTH + SSM_WIDTH, POOL_WIDTH + SSM_WIDTH + ATTN_WIDTH,
             POOL_WIDTH + SSM_WIDTH + ATTN_WIDTH + KV_WIDTH)
IN_WIDTH = POOL_WIDTH + SSM_WIDTH + ATTN_WIDTH + 2 * KV_WIDTH
D_FF = -(-8 * D_MODEL // (3 * 256)) * 256
N_MOD = 6
EPS = 1e-6

kernel_name = "hybrid_pool_s5_swa_prefix_dit"


def _rms(x, g):
    x32 = x.astype(f32)
    y = x32 * lax.rsqrt(jnp.mean(x32 * x32, axis=-1, keepdims=True) + EPS)
    return y * g.astype(f32)


def _rmsnorm(x, g):
    return _rms(x, g).astype(x.dtype)


def _axial_rope_tables(L):
    rows = L // GRID_W
    pos = jnp.arange(L)
    row = jnp.repeat(jnp.arange(rows), GRID_W, total_repeat_length=L).astype(f32)
    col = (pos % GRID_W).astype(f32)
    inv = jnp.power(ROPE_BASE, -jnp.arange(ROPE_FREQS, dtype=f32) / ROPE_FREQS)
    ang = jnp.stack([row[:, None] * inv, col[:, None] * inv], axis=1)
    return jnp.cos(ang), jnp.sin(ang)


def _apply_axial_rope(x, cos, sin):
    xs = x.reshape(x.shape[:-1] + (2, 2, ROPE_FREQS))
    x1, x2 = xs[..., 0, :], xs[..., 1, :]
    c = cos[None, :, None]
    s = sin[None, :, None]
    return jnp.stack([x1 * c - x2 * s, x2 * c + x1 * s], axis=-2).reshape(x.shape)


def _pool_mixer(u, pool_w, pool_scale):
    B, L, _ = u.shape
    u32 = u.astype(f32)
    cs = jnp.pad(jnp.cumsum(u32, axis=1), ((0, 0), (1, 0), (0, 0)))
    us = u32.reshape(B, L, len(POOL_WINDOWS), POOL_GROUP)
    css = cs.reshape(B, L + 1, len(POOL_WINDOWS), POOL_GROUP)
    t = jnp.arange(L)
    diffs = []
    for gi, w in enumerate(POOL_WINDOWS):
        lo = jnp.clip(t - w // 2, 0, L)
        hi = jnp.clip(t + w // 2, 0, L)
        csg = css[:, :, gi]
        mean = (csg[:, hi] - csg[:, lo]) / (hi - lo).astype(f32)[None, :, None]
        diffs.append(mean - us[:, :, gi])
    d = jnp.stack(diffs, axis=2)
    y = jnp.einsum('blgc,gcd->blgd', d, pool_w.astype(f32)).reshape(B, L, POOL_WIDTH)
    return (y * pool_scale.astype(f32)).astype(u.dtype)


def _scan_op(left, right):
    a_l, b_l = left
    a_r, b_r = right
    return a_l * a_r, a_r * b_l + b_r


def _linear_scan(a_bar, bu, s0):
    if s0 is not None:
        bu = bu.at[:, 0].add(a_bar * s0)
    a_full = jnp.broadcast_to(a_bar, bu.shape)
    _, s = lax.associative_scan(_scan_op, (a_full, bu), axis=1)
    return s


def _ssm_discretize(a_re, a_im, log_dt, b_re, b_im):
    lam = lax.complex(jnp.minimum(a_re.astype(f32), -1e-4), a_im.astype(f32))
    dt = jnp.exp(log_dt.astype(f32))[:, None]
    a_bar = jnp.exp(lam * dt)
    b = lax.complex(b_re.astype(f32), b_im.astype(f32))
    b_bar = ((a_bar - 1.0) / lam)[..., None] * b
    return a_bar, b_bar


def _ssm_mixer(u_x, u_c, a_re, a_im, log_dt, b_re, b_im, c_re, c_im, d_skip, glu_w, glu_b, need_ctx):
    B, L, _ = u_x.shape
    Lc = u_c.shape[1]
    ux = u_x.astype(f32).reshape(B, L, SSM_GROUPS, SSM_GROUP_CH)
    uc = u_c.astype(f32).reshape(B, Lc, SSM_GROUPS, SSM_GROUP_CH)
    dg = d_skip.astype(f32).reshape(SSM_GROUPS, SSM_GROUP_CH)
    y_x = dg * ux
    y_c = dg * uc if need_ctx else None
    for direction in (0, 1):
        a_bar, b_bar = _ssm_discretize(a_re[direction], a_im[direction], log_dt[direction],
                                       b_re[direction], b_im[direction])
        cmat = lax.complex(c_re[direction].astype(f32), c_im[direction].astype(f32))
        bu_c = jnp.einsum('gpc,blgc->blgp', b_bar, uc)
        bu_x = jnp.einsum('gpc,blgc->blgp', b_bar, ux)
        if direction == 1:
            bu_c = jnp.flip(bu_c, axis=1)
            bu_x = jnp.flip(bu_x, axis=1)
        s_c = _linear_scan(a_bar, bu_c, None)
        s_x = _linear_scan(a_bar, bu_x, s_c[:, -1])
        if direction == 1:
            s_c = jnp.flip(s_c, axis=1)
            s_x = jnp.flip(s_x, axis=1)
        y_x = y_x + jnp.real(jnp.einsum('gcp,blgp->blgc', cmat, s_x))
        if need_ctx:
            y_c = y_c + jnp.real(jnp.einsum('gcp,blgp->blgc', cmat, s_c))

    def glu(y):
        y = jax.nn.gelu(y.reshape(y.shape[0], y.shape[1], SSM_WIDTH))
        return y * jax.nn.sigmoid(y @ glu_w.astype(f32) + glu_b.astype(f32))

    out_x = glu(y_x).astype(u_x.dtype)
    out_c = glu(y_c).astype(u_c.dtype) if need_ctx else None
    return out_x, out_c


def _attn_mixer(q_x, k_x, v_x, q_c, k_c, v_c, q_norm, k_norm, sink, cos, sin, need_ctx):
    B, L, _ = q_x.shape
    Lc = k_c.shape[1]
    nb = L // BLOCK
    scale = HEAD_DIM ** -0.5
    q = _apply_axial_rope(_rms(q_x.reshape(B, L, N_HEADS, HEAD_DIM), q_norm), cos, sin)
    k = _apply_axial_rope(_rms(k_x.reshape(B, L, N_KV_HEADS, HEAD_DIM), k_norm), cos, sin)
    v = v_x.reshape(B, L, N_KV_HEADS, HEAD_DIM)
    kc = _rms(k_c.reshape(B, Lc, N_KV_HEADS, HEAD_DIM), k_norm)
    vc = v_c.reshape(B, Lc, N_KV_HEADS, HEAD_DIM)
    sink_g = sink.astype(f32).reshape(N_KV_HEADS, GROUP)

    qb = q.reshape(B, nb, BLOCK, N_KV_HEADS, GROUP, HEAD_DIM)

    def band(t):
        tp = jnp.pad(t, ((0, 0), (BLOCK, BLOCK), (0, 0), (0, 0)))
        tp = tp.reshape(B, nb + 2, BLOCK, N_KV_HEADS, HEAD_DIM)
        return jnp.concatenate([tp[:, :-2], tp[:, 1:-1], tp[:, 2:]], axis=2)

    kb, vb = band(k), band(v)
    s_win = jnp.einsum('bnqhgd,bnkhd->bnhgqk', qb, kb) * scale
    blk = jnp.arange(nb)[:, None, None]
    q_pos = blk * BLOCK + jnp.arange(BLOCK)[None, :, None]
    k_pos = (blk - 1) * BLOCK + jnp.arange(3 * BLOCK)[None, None, :]
    valid = (jnp.abs(k_pos - q_pos) <= WINDOW) & (k_pos >= 0) & (k_pos < L)
    s_win = jnp.where(valid[None, :, None, None], s_win, -jnp.inf)
    s_ctx = jnp.einsum('bnqhgd,bchd->bnhgqc', qb, kc) * scale
    s_sink = jnp.broadcast_to(sink_g[None, None, :, :, None, None], s_win.shape[:-1] + (1,))
    p = jax.nn.softmax(jnp.concatenate([s_win, s_ctx, s_sink], axis=-1), axis=-1)
    o = (jnp.einsum('bnhgqk,bnkhd->bnqhgd', p[..., :3 * BLOCK], vb.astype(f32))
         + jnp.einsum('bnhgqc,bchd->bnqhgd', p[..., 3 * BLOCK:3 * BLOCK + Lc], vc.astype(f32)))
    out_x = o.reshape(B, L, ATTN_WIDTH).astype(q_x.dtype)

    out_c = None
    if need_ctx:
        qc = _rms(q_c.reshape(B, Lc, N_HEADS, HEAD_DIM), q_norm).reshape(B, Lc, N_KV_HEADS, GROUP, HEAD_DIM)
        sc = jnp.einsum('bqhgd,bkhd->bhgqk', qc, kc) * scale
        sc_sink = jnp.broadcast_to(sink_g[None, :, :, None, None], sc.shape[:-1] + (1,))
        pc = jax.nn.softmax(jnp.concatenate([sc, sc_sink], axis=-1), axis=-1)
        oc = jnp.einsum('bhgqk,bkhd->bqhgd', pc[..., :Lc], vc.astype(f32))
        out_c = oc.reshape(B, Lc, ATTN_WIDTH).astype(q_c.dtype)
    return out_x, out_c


def _mixing(hx, hc, w_in, w_out, pool_w, pool_scale, a_re, a_im, log_dt, b_re, b_im, c_re, c_im,
            d_skip, glu_w, glu_b, q_norm, k_norm, sink, cos, sin, need_ctx):
    pool_x, ssm_x, q_x, k_x, v_x = jnp.split(hx @ w_in, IN_SPLITS, axis=-1)
    pool_c, ssm_c, q_c, k_c, v_c = jnp.split(hc @ w_in, IN_SPLITS, axis=-1)
    po_x = _pool_mixer(pool_x, pool_w, pool_scale)
    so_x, so_c = _ssm_mixer(ssm_x, ssm_c, a_re, a_im, log_dt, b_re, b_im, c_re, c_im,
                            d_skip, glu_w, glu_b, need_ctx)
    ao_x, ao_c = _attn_mixer(q_x, k_x, v_x, q_c, k_c, v_c, q_norm, k_norm, sink, cos, sin, need_ctx)
    out_x = jnp.concatenate([po_x, so_x, ao_x], axis=-1) @ w_out
    out_c = None
    if need_ctx:
        po_c = _pool_mixer(pool_c, pool_w, pool_scale)
        out_c = jnp.concatenate([po_c, so_c, ao_c], axis=-1) @ w_out
    return out_x, out_c


def _swiglu(h, w_gate, w_up, w_down):
    return (jax.nn.silu(h @ w_gate) * (h @ w_up)) @ w_down


def setup_inputs(seed: int = 0) -> dict:
    key = jax.random.key(seed)
    ks = jax.random.split(key, 32)
    nrm = jax.random.normal
    D = D_MODEL
    a_im0 = math.pi * jnp.arange(SSM_STATE, dtype=f32)
    return {
        "x": nrm(ks[0], (BATCH, SEQ, D), f32),
        "c": nrm(ks[1], (BATCH, D), f32),
        "ctx": nrm(ks[2], (BATCH, CTX_LEN, D), f32),
        "c_ctx": nrm(ks[3], (D,), f32),
        "w_mod": nrm(ks[4], (DEPTH, D, N_MOD * D), f32) * (0.5 * D ** -0.5),
        "b_mod": nrm(ks[5], (DEPTH, N_MOD * D), f32) * 0.02,
        "norm_mix": 1.0 + 0.02 * nrm(ks[6], (DEPTH, D), f32),
        "norm_ffn": 1.0 + 0.02 * nrm(ks[7], (DEPTH, D), f32),
        "w_in": nrm(ks[8], (DEPTH, D, IN_WIDTH), f32) * D ** -0.5,
        "w_out": nrm(ks[9], (DEPTH, D_MIX, D), f32) * D_MIX ** -0.5,
        "pool_w": nrm(ks[10], (DEPTH, len(POOL_WINDOWS), POOL_GROUP, POOL_GROUP), f32) * POOL_GROUP ** -0.5,
        "pool_scale": 1.0 + 0.1 * nrm(ks[11], (DEPTH, POOL_WIDTH), f32),
        "ssm_a_re": -0.5 + 0.01 * nrm(ks[12], (DEPTH, 2, SSM_GROUPS, SSM_STATE), f32),
        "ssm_a_im": a_im0 + 0.01 * nrm(ks[13], (DEPTH, 2, SSM_GROUPS, SSM_STATE), f32),
        "ssm_log_dt": jax.random.uniform(ks[14], (DEPTH, 2, SSM_GROUPS), f32,
                                         math.log(1e-3), math.log(1e-1)),
        "ssm_b_re": nrm(ks[15], (DEPTH, 2, SSM_GROUPS, SSM_STATE, SSM_GROUP_CH), f32) * (0.5 / SSM_GROUP_CH) ** 0.5,
        "ssm_b_im": nrm(ks[16], (DEPTH, 2, SSM_GROUPS, SSM_STATE, SSM_GROUP_CH), f32) * (0.5 / SSM_GROUP_CH) ** 0.5,
        "ssm_c_re": nrm(ks[17], (DEPTH, 2, SSM_GROUPS, SSM_GROUP_CH, SSM_STATE), f32) * (0.5 / SSM_STATE) ** 0.5,
        "ssm_c_im": nrm(ks[18], (DEPTH, 2, SSM_GROUPS, SSM_GROUP_CH, SSM_STATE), f32) * (0.5 / SSM_STATE) ** 0.5,
        "ssm_d": nrm(ks[19], (DEPTH, SSM_WIDTH), f32),
        "ssm_glu_w": nrm(ks[20], (DEPTH, SSM_WIDTH, SSM_WIDTH), f32) * SSM_WIDTH ** -0.5,
        "ssm_glu_b": 0.02 * nrm(ks[21], (DEPTH, SSM_WIDTH), f32),
        "q_norm": 1.0 + 0.02 * nrm(ks[22], (DEPTH, HEAD_DIM), f32),
        "k_norm": 1.0 + 0.02 * nrm(ks[23], (DEPTH, HEAD_DIM), f32),
        "attn_sink": 0.5 * nrm(ks[24], (DEPTH, N_HEADS), f32),
        "ffn_w_gate": nrm(ks[25], (DEPTH, D, D_FF), f32) * D ** -0.5,
        "ffn_w_up": nrm(ks[26], (DEPTH, D, D_FF), f32) * D ** -0.5,
        "ffn_w_down": nrm(ks[27], (DEPTH, D_FF, D), f32) * D_FF ** -0.5,
    }


def reference(x, c, ctx, c_ctx, w_mod, b_mod, norm_mix, norm_ffn, w_in, w_out, pool_w, pool_scale,
              ssm_a_re, ssm_a_im, ssm_log_dt, ssm_b_re, ssm_b_im, ssm_c_re, ssm_c_im, ssm_d,
              ssm_glu_w, ssm_glu_b, q_norm, k_norm, attn_sink, ffn_w_gate, ffn_w_up, ffn_w_down):
    L = x.shape[1]
    cos, sin = _axial_rope_tables(L)
    silu_c = jax.nn.silu(c)
    silu_cc = jax.nn.silu(c_ctx)
    for l in range(DEPTH):
        need_ctx = l < DEPTH - 1
        mx = silu_c @ w_mod[l] + b_mod[l]
        mc = silu_cc @ w_mod[l] + b_mod[l]
        sh1, sc1, g1, sh2, sc2, g2 = jnp.split(mx[:, None, :], N_MOD, axis=-1)
        csh1, csc1, cg1, csh2, csc2, cg2 = jnp.split(mc, N_MOD, axis=-1)

        hx = _rmsnorm(x, norm_mix[l]) * (1.0 + sc1) + sh1
        hc = _rmsnorm(ctx, norm_mix[l]) * (1.0 + csc1) + csh1
        mix_x, mix_c = _mixing(hx, hc, w_in[l], w_out[l], pool_w[l], pool_scale[l],
                               ssm_a_re[l], ssm_a_im[l], ssm_log_dt[l], ssm_b_re[l], ssm_b_im[l],
                               ssm_c_re[l], ssm_c_im[l], ssm_d[l], ssm_glu_w[l], ssm_glu_b[l],
                               q_norm[l], k_norm[l], attn_sink[l], cos, sin, need_ctx)
        x = x + g1 * mix_x
        hx2 = _rmsnorm(x, norm_ffn[l]) * (1.0 + sc2) + sh2
        x = x + g2 * _swiglu(hx2, ffn_w_gate[l], ffn_w_up[l], ffn_w_down[l])

        if need_ctx:
            ctx = ctx + cg1 * mix_c
            hc2 = _rmsnorm(ctx, norm_ffn[l]) * (1.0 + csc2) + csh2
            ctx = ctx + cg2 * _swiglu(hc2, ffn_w_gate[l], ffn_w_up[l], ffn_w_down[l])
    return x
```

```cpp
#include <hip/hip_runtime.h>
#include <hip/hip_cooperative_groups.h>
#include <stdint.h>
#include <stdio.h>
namespace cg = cooperative_groups;

#ifndef MEGA
#define MEGA 1
#endif

typedef unsigned short bf16_t;
using bf16x8 = __attribute__((ext_vector_type(8))) short;
using f32x4 = __attribute__((ext_vector_type(4))) float;
using f32x16 = __attribute__((ext_vector_type(16))) float;
#define DI __device__ __forceinline__
#define MFMA16(a, b, c) __builtin_amdgcn_mfma_f32_16x16x32_bf16((a), (b), (c), 0, 0, 0)
#define MFMA32(a, b, c) __builtin_amdgcn_mfma_f32_32x32x16_bf16((a), (b), (c), 0, 0, 0)

constexpr int NLAT = 16384, NROW = 18432, DM = 1024, INW = 1280, DFF = 2816;
constexpr int LDS_PHASE = 65536;
constexpr int LDS_BYTES = LDS_PHASE + 16;
constexpr int NTHREADS = 256;

constexpr size_t OFF_XRES = 0;
constexpr size_t OFF_H = OFF_XRES + (size_t)NROW * DM * 4;
constexpr size_t OFF_UNI = OFF_H + (size_t)NROW * DM * 2;
constexpr size_t OFF_PROJ = OFF_UNI;
constexpr size_t OFF_CAT = OFF_PROJ + (size_t)NROW * INW * 2;
constexpr size_t OFF_YSSM = OFF_CAT + (size_t)NROW * DM * 2;
constexpr size_t OFF_VT = OFF_YSSM;
constexpr size_t OFF_ACT = OFF_UNI;
constexpr size_t OFF_W = OFF_YSSM + (size_t)2 * NROW * 256 * 4;
constexpr size_t W_IN_E = (size_t)INW * DM, W_OUT_E = (size_t)DM * DM, W_GU_E = (size_t)2 * DFF * DM, W_D_E = (size_t)DM * DFF, W_GLU_E = 65536;
constexpr size_t OFF_WIN = OFF_W;
constexpr size_t OFF_WOUT = OFF_WIN + 4 * W_IN_E * 2;
constexpr size_t OFF_WGU = OFF_WOUT + 4 * W_OUT_E * 2;
constexpr size_t OFF_WD = OFF_WGU + 4 * W_GU_E * 2;
constexpr size_t OFF_GLUT = OFF_WD + 4 * W_D_E * 2;
constexpr size_t OFF_MOD = OFF_GLUT + 4 * W_GLU_E * 2;
constexpr size_t OFF_KTAB = OFF_MOD + (size_t)4 * 9 * 6144 * 4;
constexpr size_t OFF_ETAB = OFF_KTAB + (size_t)128 * 16384 * 2;
constexpr size_t OFF_FTAB = OFF_ETAB + (size_t)128 * 131072 * 2;
constexpr size_t OFF_AT = OFF_FTAB + (size_t)128 * 131072 * 2;
constexpr size_t OFF_ROPE = OFF_AT + (size_t)128 * 64 * 8;
constexpr size_t OFF_BAR = OFF_ROPE + 64 * 16 * 8;
constexpr size_t BAR_BYTES = 3456 * 4;
constexpr size_t OFF_POOLT = OFF_BAR + BAR_BYTES;
constexpr size_t WS_END = OFF_POOLT + (size_t)4 * 4 * 64 * 64 * 2;
constexpr size_t OFF_SLOC = OFF_H;

struct Params {
  const float *x, *c, *ctx, *c_ctx, *w_mod, *b_mod, *norm_mix, *norm_ffn, *w_in, *w_out, *pool_w, *pool_scale;
  const float *a_re, *a_im, *log_dt, *b_re, *b_im, *c_re, *c_im, *ssm_d, *glu_w, *glu_b, *q_norm, *k_norm, *sink;
  const float *w_gate, *w_up, *w_down;
  float* out;
  char* ws;
};

DI unsigned short f2bf(float x) { unsigned u = __float_as_uint(x); u += 0x7fffu + ((u >> 16) & 1u); return (unsigned short)(u >> 16); }
DI float bf2f(unsigned short h) { return __uint_as_float(((unsigned)h) << 16); }
DI unsigned pack2(float a, float b) { unsigned r; asm("v_cvt_pk_bf16_f32 %0, %1, %2\n\ts_nop 1" : "=v"(r) : "v"(a), "v"(b)); return r; }
DI float bflo(unsigned u) { return __uint_as_float(u << 16); }
DI float bfhi(unsigned u) { return __uint_as_float(u & 0xffff0000u); }
DI int otid() { int t = threadIdx.x; asm volatile("" : "+v"(t)); return t; }
DI float frcp(float x) { return __builtin_amdgcn_rcpf(x); }
DI int crow32(int i, int h) { return (i & 3) + 8 * (i >> 2) + 4 * h; }

DI void sincos_d(double x, double* sn, double* cs) {
  const double kd = rint(x * 0.6366197723675814);
  double r = fma(-kd, 1.5707963267948966, x);
  r = fma(-kd, 6.123233995736766e-17, r);
  const int k = ((int)kd) & 3;
  const double r2 = r * r;
  const double sp = r + r * r2 * (-1.0 / 6 + r2 * (1.0 / 120 + r2 * (-1.0 / 5040 + r2 * (1.0 / 362880 + r2 * (-1.0 / 39916800 + r2 * (1.0 / 6227020800.0 + r2 * (-1.0 / 1307674368000.0)))))));
  const double cp = 1.0 + r2 * (-0.5 + r2 * (1.0 / 24 + r2 * (-1.0 / 720 + r2 * (1.0 / 40320 + r2 * (-1.0 / 3628800 + r2 * (1.0 / 479001600 + r2 * (-1.0 / 87178291200.0)))))));
  const double s0 = (k & 1) ? cp : sp, c0 = (k & 1) ? sp : cp;
  *sn = (k & 2) ? -s0 : s0;
  *cs = ((k + 1) & 2) ? -c0 : c0;
}
DI void pro_ssm(const Params& P, int item, char* smem) {
  const int tid = otid();
  const int tb = item >> 2, qt = item & 3;
  const int l = tb >> 5, g = (tb >> 1) & 15, dir = tb & 1;
  const int ig = (l * 2 + dir) * 16 + g;
  float2* apow = (float2*)smem;
  float2* bbar = apow + 65 * 64;
  float2* cm = bbar + 64 * 16;
  const double dt = exp((double)P.log_dt[ig]);
  {
    const int p = tid & 63;
    const double lre = fmin((double)P.a_re[ig * 64 + p], -1e-4), lim = (double)P.a_im[ig * 64 + p];
#pragma unroll 1
    for (int e = tid >> 6; e <= 64; e += 4) {
      double mag = exp(lre * dt * (double)e), sn, cs;
      sincos_d(lim * dt * (double)e, &sn, &cs);
      apow[e * 64 + p] = make_float2((float)(mag * cs), (float)(mag * sn));
    }
  }
#pragma unroll 1
  for (int i = 0; i < 4; ++i) {
    const int idx = tid + 256 * i, p = idx >> 4, c = idx & 15;
    const double lre = fmin((double)P.a_re[ig * 64 + p], -1e-4), lim = (double)P.a_im[ig * 64 + p];
    double mag = exp(lre * dt), sn, cs;
    sincos_d(lim * dt, &sn, &cs);
    const double nre = mag * cs - 1.0, nim = mag * sn;
    const double den = lre * lre + lim * lim;
    const double cre = (nre * lre + nim * lim) / den, cim = (nim * lre - nre * lim) / den;
    const double bre = (double)P.b_re[(size_t)(ig * 64 + p) * 16 + c], bim = (double)P.b_im[(size_t)(ig * 64 + p) * 16 + c];
    bbar[p * 16 + c] = make_float2((float)(cre * bre - cim * bim), (float)(cre * bim + cim * bre));
    const int c2 = idx >> 6, p2 = idx & 63;
    cm[c2 * 64 + p2] = make_float2(P.c_re[(size_t)(ig * 16 + c2) * 64 + p2], P.c_im[(size_t)(ig * 16 + c2) * 64 + p2]);
  }
  __syncthreads();
  bf16_t* KT = (bf16_t*)(P.ws + OFF_KTAB) + (size_t)tb * 16384;
  bf16_t* ET = (bf16_t*)(P.ws + OFF_ETAB) + (size_t)tb * 131072;
  bf16_t* FT = (bf16_t*)(P.ws + OFF_FTAB) + (size_t)tb * 131072;
  {
    const int ci = tid & 15, co = tid >> 4;
#pragma unroll 1
    for (int tt = 0; tt < 16; ++tt) {
      const int tau = qt * 16 + tt;
      float acc = 0.f;
#pragma unroll 4
      for (int p = 0; p < 64; ++p) {
        const float2 cc = cm[co * 64 + p], aa = apow[tau * 64 + p], bb = bbar[p * 16 + ci];
        const float xr = cc.x * aa.x - cc.y * aa.y, xi = cc.x * aa.y + cc.y * aa.x;
        acc += xr * bb.x - xi * bb.y;
      }
      KT[tau * 256 + co * 16 + ci] = f2bf(acc);
    }
  }
  {
    const int c = tid & 15, ol = tid >> 4, off = qt * 16 + ol;
    const int e = dir == 0 ? 63 - off : off;
#pragma unroll 2
    for (int p = 0; p < 64; ++p) {
      const float2 aa = apow[e * 64 + p], bb = bbar[p * 16 + c];
      ET[(size_t)p * 1024 + off * 16 + c] = f2bf(aa.x * bb.x - aa.y * bb.y);
      ET[(size_t)(64 + p) * 1024 + off * 16 + c] = f2bf(aa.x * bb.y + aa.y * bb.x);
    }
  }
  {
    const int col = tid & 127, half = tid >> 7, p = col & 63, part = col >> 6;
#pragma unroll 2
    for (int rr = 0; rr < 128; ++rr) {
      const int rowl = half * 128 + rr, off = qt * 16 + (rowl >> 4), co = rowl & 15;
      const int e = dir == 0 ? off + 1 : 64 - off;
      const float2 cc = cm[co * 64 + p], aa = apow[e * 64 + p];
      const float vr = cc.x * aa.x - cc.y * aa.y, vi = cc.x * aa.y + cc.y * aa.x;
      FT[(size_t)(off * 16 + co) * 128 + col] = f2bf(part == 0 ? vr : -vi);
    }
  }
  if (qt == 0 && tid < 64) ((float2*)(P.ws + OFF_AT))[tb * 64 + tid] = apow[64 * 64 + tid];
}

DI void pro_mod(const Params& P, int item, char* smem) {
  const int tid = otid();
  const int l = item / 96, n0 = (item % 96) * 64;
  float* sl = (float*)smem;
  float* red = sl;
  for (int i = tid; i < 9 * 1024; i += 256) {
    const int r = i >> 10, k = i & 1023;
    const float v = r < 8 ? P.c[r * 1024 + k] : P.c_ctx[k];
    sl[i] = v / (1.f + __expf(-v));
  }
  __syncthreads();
  const int kq = tid >> 4, cq = tid & 15;
  float acc[9][4];
#pragma unroll
  for (int r = 0; r < 9; ++r) { acc[r][0] = acc[r][1] = acc[r][2] = acc[r][3] = 0.f; }
  const float* wp = P.w_mod + (size_t)l * 1024 * 6144 + n0 + cq * 4;
#pragma unroll 4
  for (int i = 0; i < 64; ++i) {
    const int k = kq + 16 * i;
    const float4 w = *(const float4*)(wp + (size_t)k * 6144);
#pragma unroll
    for (int r = 0; r < 9; ++r) {
      const float s = sl[r * 1024 + k];
      acc[r][0] += s * w.x; acc[r][1] += s * w.y; acc[r][2] += s * w.z; acc[r][3] += s * w.w;
    }
  }
  __syncthreads();
#pragma unroll
  for (int r = 0; r < 9; ++r)
#pragma unroll
    for (int j = 0; j < 4; ++j) red[(kq * 9 + r) * 64 + cq * 4 + j] = acc[r][j];
  __syncthreads();
  float* MOD = (float*)(P.ws + OFF_MOD);
  for (int o = tid; o < 9 * 64; o += 256) {
    const int r = o >> 6, cc = o & 63;
    float s = P.b_mod[l * 6144 + n0 + cc];
    for (int q = 0; q < 16; ++q) s += red[(q * 9 + r) * 64 + cc];
    MOD[(size_t)(l * 9 + r) * 6144 + n0 + cc] = s;
  }
}

DI void pro_poolw(const Params& P, int item) {
  const int tid = otid();
  bf16_t* PT = (bf16_t*)(P.ws + OFF_POOLT);
  float v[16];
#pragma unroll
  for (int i = 0; i < 16; ++i) {
    const int e = item * 4096 + i * 256 + tid, lg = e >> 12, o = (e >> 6) & 63, c = e & 63;
    v[i] = P.pool_w[(size_t)lg * 4096 + c * 64 + o];
  }
#pragma unroll
  for (int i = 0; i < 16; ++i) PT[item * 4096 + i * 256 + tid] = f2bf(v[i]);
}

DI void pro_rope(const Params& P) {
  float2* R = (float2*)(P.ws + OFF_ROPE);
  for (int i = otid(); i < 1024; i += 256) {
    const int v = i >> 4, f = i & 15;
    const double inv = exp(-(double)f * (9.210340371976184 / 16.0));
    double sn, cs;
    sincos_d((double)v * inv, &sn, &cs);
    R[i] = make_float2((float)cs, (float)sn);
  }
}

DI void pro_transpose(const Params& P, int idx, char* smem) {
  const int tid = otid();
  const int l = idx / 2704;
  int r = idx % 2704;
  const float* src; bf16_t* dst; int K, N, kt, nt, rs = 16, ro = 0;
  if (r < 320) { src = P.w_in + (size_t)l * 1024 * 1280; dst = (bf16_t*)(P.ws + OFF_WIN) + l * W_IN_E; K = 1024; N = 1280; kt = r / 20; nt = r % 20; }
  else if (r < 576) { r -= 320; src = P.w_out + (size_t)l * 1024 * 1024; dst = (bf16_t*)(P.ws + OFF_WOUT) + l * W_OUT_E; K = 1024; N = 1024; kt = r / 16; nt = r % 16; }
  else if (r < 1280) { r -= 576; src = P.w_gate + (size_t)l * 1024 * 2816; dst = (bf16_t*)(P.ws + OFF_WGU) + l * W_GU_E; K = 1024; N = 2816; kt = r / 44; nt = r % 44; rs = 32; }
  else if (r < 1984) { r -= 1280; src = P.w_up + (size_t)l * 1024 * 2816; dst = (bf16_t*)(P.ws + OFF_WGU) + l * W_GU_E; K = 1024; N = 2816; kt = r / 44; nt = r % 44; rs = 32; ro = 16; }
  else if (r < 2688) { r -= 1984; src = P.w_down + (size_t)l * 2816 * 1024; dst = (bf16_t*)(P.ws + OFF_WD) + l * W_D_E; K = 2816; N = 1024; kt = r / 16; nt = r % 16; }
  else { r -= 2688; src = P.glu_w + (size_t)l * 65536; dst = (bf16_t*)(P.ws + OFF_GLUT) + l * W_GLU_E; K = 256; N = 256; kt = r / 4; nt = r % 4; }
  float* tile = (float*)smem;
  const int k0 = kt * 64, n0 = nt * 64;
  {
    const int kr = tid >> 4, nc = (tid & 15) * 4;
#pragma unroll
    for (int i = 0; i < 4; ++i) {
      const float4 v = *(const float4*)(src + (size_t)(k0 + kr + 16 * i) * N + n0 + nc);
      tile[(nc + 0) * 65 + kr + 16 * i] = v.x; tile[(nc + 1) * 65 + kr + 16 * i] = v.y;
      tile[(nc + 2) * 65 + kr + 16 * i] = v.z; tile[(nc + 3) * 65 + kr + 16 * i] = v.w;
    }
  }
  __syncthreads();
  {
    const int n = tid >> 2, kq = (tid & 3) * 16;
    const int ng = n0 + n;
    const int drow = (ng >> 4) * rs + (ng & 15) + ro;
    unsigned o[8];
#pragma unroll
    for (int j = 0; j < 8; ++j) o[j] = pack2(tile[n * 65 + kq + 2 * j], tile[n * 65 + kq + 2 * j + 1]);
    uint4* d = (uint4*)(dst + (size_t)drow * K + k0 + kq);
    d[0] = make_uint4(o[0], o[1], o[2], o[3]);
    d[1] = make_uint4(o[4], o[5], o[6], o[7]);
  }
}

DI void pro_copy(const Params& P, int item) {
  const int tid = otid();
  const size_t base = (size_t)item * 4096;
  float4* dst = (float4*)(P.ws + OFF_XRES);
#pragma unroll
  for (int i = 0; i < 4; ++i) {
    const size_t e = base + (size_t)(tid + 256 * i) * 4;
    const float4 v = e < (size_t)NLAT * DM ? *(const float4*)(P.x + e) : *(const float4*)(P.ctx + (e - (size_t)NLAT * DM));
    dst[e >> 2] = v;
  }
}

constexpr int PRO_SSM = 512, PRO_MOD = 384, PRO_TR = 10816, PRO_PW = 16;
constexpr int PRO_ITEMS = PRO_SSM + PRO_MOD + 1 + PRO_PW + PRO_TR;

DI void ph_prologue(const Params& P, char* smem) {
  for (int item = blockIdx.x; item < PRO_ITEMS; item += gridDim.x) {
    if (item < PRO_SSM) pro_ssm(P, item, smem);
    else if (item < PRO_SSM + PRO_MOD) pro_mod(P, item - PRO_SSM, smem);
    else if (item < PRO_SSM + PRO_MOD + 1) pro_rope(P);
    else if (item < PRO_SSM + PRO_MOD + 1 + PRO_PW) pro_poolw(P, item - (PRO_SSM + PRO_MOD + 1));
    else pro_transpose(P, item - (PRO_SSM + PRO_MOD + 1 + PRO_PW), smem);
    __syncthreads();
  }
}

DI void ph_norm(const Params& P, int l, int which, int nrows) {
  const bool seed = (l == 0 && which == 0);
  const int tid = otid(), lane = tid & 63, w = tid >> 6;
  float* XR = (float*)(P.ws + OFF_XRES);
  bf16_t* H = (bf16_t*)(P.ws + OFF_H);
  const float* MOD = (const float*)(P.ws + OFF_MOD);
  const float* g = (which ? P.norm_ffn : P.norm_mix) + l * 1024;
  for (int row = blockIdx.x * 4 + w; row < nrows; row += gridDim.x * 4) {
    const float4* xr = seed ? (const float4*)(row < NLAT ? P.x + (size_t)row * 1024 : P.ctx + (size_t)(row - NLAT) * 1024) : (const float4*)(XR + (size_t)row * 1024);
    float4 v[4];
    float ss = 0.f;
#pragma unroll
    for (int i = 0; i < 4; ++i) { v[i] = xr[lane + 64 * i]; ss += v[i].x * v[i].x + v[i].y * v[i].y + v[i].z * v[i].z + v[i].w * v[i].w; }
#pragma unroll
    for (int m = 32; m >= 1; m >>= 1) ss += __shfl_xor(ss, m);
    const float rstd = rsqrtf(ss * (1.f / 1024.f) + 1e-6f);
    if (seed) {
#pragma unroll
      for (int i = 0; i < 4; ++i) ((float4*)(XR + (size_t)row * 1024))[lane + 64 * i] = v[i];
    }
    const int mr = row < NLAT ? (row >> 11) : 8;
    const float* mp = MOD + (size_t)(l * 9 + mr) * 6144;
    const float* sh = mp + (which ? 3 : 0) * 1024;
    const float* sc = mp + (which ? 4 : 1) * 1024;
#pragma unroll
    for (int i = 0; i < 4; ++i) {
      const int col = (lane + 64 * i) * 4;
      const float4 gg = *(const float4*)(g + col), s1 = *(const float4*)(sc + col), s0 = *(const float4*)(sh + col);
      const float h0 = v[i].x * rstd * gg.x * (1.f + s1.x) + s0.x;
      const float h1 = v[i].y * rstd * gg.y * (1.f + s1.y) + s0.y;
      const float h2 = v[i].z * rstd * gg.z * (1.f + s1.z) + s0.z;
      const float h3 = v[i].w * rstd * gg.w * (1.f + s1.w) + s0.w;
      *(uint2*)(H + (size_t)row * 1024 + col) = make_uint2(pack2(h0, h1), pack2(h2, h3));
    }
  }
}

#define LDSAS __attribute__((address_space(3)))
DI void glds_tile(const bf16_t* gA, const bf16_t* gB, int K, int kt, bf16_t* sA, bf16_t* sB, int buf, int w, int lane) {
  const int c = (lane & 7) ^ (lane >> 3);
#pragma unroll
  for (int j = 0; j < 4; ++j) {
    const int rb = 4 * w + j, row = 8 * rb + (lane >> 3);
    const bf16_t* srcA = gA + (size_t)row * K + kt * 64 + c * 8;
    const bf16_t* srcB = gB + (size_t)row * K + kt * 64 + c * 8;
    bf16_t* dA = sA + buf * 128 * 64 + rb * 512 + lane * 8;
    bf16_t* dB = sB + buf * 128 * 64 + rb * 512 + lane * 8;
    __builtin_amdgcn_global_load_lds((const void*)srcA, (LDSAS void*)dA, 16, 0, 0);
    __builtin_amdgcn_global_load_lds((const void*)srcB, (LDSAS void*)dB, 16, 0, 0);
  }
}

template <int EPI>
DI void ph_gemm(const Params& P, int l, const bf16_t* __restrict__ A, const bf16_t* __restrict__ Bt, int M, int N, int K,
                int gidx, bool final_out, char* smem) {
  const int tid = otid(), lane = tid & 63, w = tid >> 6, wr = w >> 1, wc = w & 1, fr = lane & 15, fq = lane >> 4;
  bf16_t* sA = (bf16_t*)smem;
  bf16_t* sB = sA + 2 * 128 * 64;
  const int tm = M >> 7, tn = N >> 7, ntiles = tm * tn, nk = K >> 6;
  const int lrow = tid >> 3, lk = (tid & 7) * 8;
  const int lsw = ((tid & 7) ^ (lrow & 7)) * 8;
  auto tile_of = [&](int s_, int& m0_, int& n0_) {
    const int t = (s_ & 7) * (ntiles >> 3) + (s_ >> 3);
    const int grp = t / (8 * tn), rem = t % (8 * tn);
    m0_ = (grp * 8 + (rem & 7)) << 7; n0_ = (rem >> 3) << 7;
  };
  if ((int)blockIdx.x < ntiles) {
    int m0, n0; tile_of(blockIdx.x, m0, n0);
    glds_tile(A + (size_t)m0 * K, Bt + (size_t)n0 * K, K, 0, sA, sB, 0, w, lane);
  }
  for (int s = blockIdx.x; s < ntiles; s += gridDim.x) {
    int m0, n0; tile_of(s, m0, n0);
    const bool has_next = s + (int)gridDim.x < ntiles;
    int m0n = 0, n0n = 0;
    if (has_next) tile_of(s + gridDim.x, m0n, n0n);
    f32x4 acc[4][4];
#pragma unroll
    for (int m = 0; m < 4; ++m)
#pragma unroll
      for (int n = 0; n < 4; ++n) acc[m][n] = f32x4{0.f, 0.f, 0.f, 0.f};
    const bf16_t* gA = A + (size_t)m0 * K;
    const bf16_t* gB = Bt + (size_t)n0 * K;
    asm volatile("s_waitcnt vmcnt(0)" ::: "memory");
    __syncthreads();
    for (int kt = 0; kt < nk; ++kt) {
      const int cur = kt & 1;
      if (kt + 1 < nk) glds_tile(gA, gB, K, kt + 1, sA, sB, cur ^ 1, w, lane);
      else if (has_next) glds_tile(A + (size_t)m0n * K, Bt + (size_t)n0n * K, K, 0, sA, sB, 0, w, lane);
      const bf16_t* cA = sA + cur * 128 * 64 + (wr * 64 + fr) * 64;
      const bf16_t* cB = sB + cur * 128 * 64 + (wc * 64 + fr) * 64;
#pragma unroll
      for (int ks = 0; ks < 2; ++ks) {
        bf16x8 af[4], bfr[4];
#pragma unroll
        for (int m = 0; m < 4; ++m) af[m] = *(const bf16x8*)(cA + m * 16 * 64 + (((ks * 4 + fq) ^ (fr & 7)) * 8));
#pragma unroll
        for (int n = 0; n < 4; ++n) bfr[n] = *(const bf16x8*)(cB + n * 16 * 64 + (((ks * 4 + fq) ^ (fr & 7)) * 8));
        __builtin_amdgcn_s_setprio(1);
#pragma unroll
        for (int m = 0; m < 4; ++m)
#pragma unroll
          for (int n = 0; n < 4; ++n) acc[m][n] = MFMA16(bfr[n], af[m], acc[m][n]);
        __builtin_amdgcn_s_setprio(0);
      }
      if (kt + 1 < nk) {
        asm volatile("s_waitcnt vmcnt(0)" ::: "memory");
        __syncthreads();
      }
    }
    if (EPI == 0) {
      bf16_t* C = (bf16_t*)(P.ws + OFF_PROJ);
      const int col0 = n0 + wc * 64;
      if (col0 >= 512 && col0 < 1152) {
        const bool isq = col0 < 1024;
        const float* nw = (isq ? P.q_norm : P.k_norm) + l * 64 + fq * 4;
        const float2* ROPE = (const float2*)(P.ws + OFF_ROPE);
        float nwv[4][4];
#pragma unroll
        for (int n = 0; n < 4; ++n)
#pragma unroll
          for (int j = 0; j < 4; ++j) nwv[n][j] = nw[n * 16 + j];
#pragma unroll
        for (int m = 0; m < 4; ++m) {
          float ss = 0.f;
#pragma unroll
          for (int n = 0; n < 4; ++n)
#pragma unroll
            for (int j = 0; j < 4; ++j) ss += acc[m][n][j] * acc[m][n][j];
          ss += __shfl_xor(ss, 16);
          ss += __shfl_xor(ss, 32);
          const float rs = rsqrtf(ss * (1.f / 64.f) + 1e-6f) * (isq ? 0.125f * 1.4426950408889634f : 1.f);
#pragma unroll
          for (int n = 0; n < 4; ++n)
#pragma unroll
            for (int j = 0; j < 4; ++j) acc[m][n][j] *= rs * nwv[n][j];
          const int row = m0 + wr * 64 + m * 16 + fr;
          if (row < NLAT) {
            const int t = row & 2047;
#pragma unroll
            for (int a = 0; a < 2; ++a) {
              const int v = a == 0 ? (t >> 6) : (t & 63);
#pragma unroll
              for (int j = 0; j < 4; ++j) {
                const float2 cssn = ROPE[v * 16 + fq * 4 + j];
                const float x1 = acc[m][2 * a][j], x2 = acc[m][2 * a + 1][j];
                acc[m][2 * a][j] = x1 * cssn.x - x2 * cssn.y;
                acc[m][2 * a + 1][j] = x2 * cssn.x + x1 * cssn.y;
              }
            }
          }
        }
      }
      if (col0 >= 1152) {
        bf16_t* VT = (bf16_t*)(P.ws + OFF_VT);
#pragma unroll
        for (int m = 0; m < 4; ++m) {
          const int row = m0 + wr * 64 + m * 16 + fr;
#pragma unroll
          for (int n = 0; n < 4; ++n)
#pragma unroll
            for (int j = 0; j < 4; ++j) VT[(size_t)(col0 - 1152 + n * 16 + fq * 4 + j) * NROW + row] = f2bf(acc[m][n][j]);
        }
      } else {
#pragma unroll
        for (int m = 0; m < 4; ++m) {
          const int row = m0 + wr * 64 + m * 16 + fr;
#pragma unroll
          for (int n = 0; n < 4; ++n) {
            const int col = col0 + n * 16 + fq * 4;
            *(uint2*)(C + (size_t)row * N + col) = make_uint2(pack2(acc[m][n][0], acc[m][n][1]), pack2(acc[m][n][2], acc[m][n][3]));
          }
        }
      }
    } else if (EPI == 1) {
      float* XR = (float*)(P.ws + OFF_XRES);
      const float* MOD = (const float*)(P.ws + OFF_MOD);
      const int mr = m0 < NLAT ? (m0 >> 11) : 8;
      const float* gp = MOD + (size_t)(l * 9 + mr) * 6144 + gidx * 1024 + n0 + wc * 64 + fq * 4;
      float4 gg[4];
#pragma unroll
      for (int n = 0; n < 4; ++n) gg[n] = *(const float4*)(gp + n * 16);
      float* xbase = XR + (size_t)(m0 + wr * 64 + fr) * 1024 + n0 + wc * 64 + fq * 4;
      float4 xv[4][4];
#pragma unroll
      for (int m = 0; m < 4; ++m)
#pragma unroll
        for (int n = 0; n < 4; ++n) xv[m][n] = *(const float4*)(xbase + (size_t)m * 16 * 1024 + n * 16);
      float* obase = final_out ? P.out + (size_t)(m0 + wr * 64 + fr) * 1024 + n0 + wc * 64 + fq * 4 : xbase;
#pragma unroll
      for (int m = 0; m < 4; ++m)
#pragma unroll
        for (int n = 0; n < 4; ++n) {
          float4 o;
          o.x = xv[m][n].x + gg[n].x * acc[m][n][0]; o.y = xv[m][n].y + gg[n].y * acc[m][n][1];
          o.z = xv[m][n].z + gg[n].z * acc[m][n][2]; o.w = xv[m][n].w + gg[n].w * acc[m][n][3];
          *(float4*)(obase + (size_t)m * 16 * 1024 + n * 16) = o;
        }
    } else {
      bf16_t* ACT = (bf16_t*)(P.ws + OFF_ACT);
#pragma unroll
      for (int m = 0; m < 4; ++m) {
        const int row = m0 + wr * 64 + m * 16 + fr;
#pragma unroll
        for (int i = 0; i < 2; ++i) {
          const int col = (n0 >> 1) + wc * 32 + i * 16 + fq * 4;
          float o[4];
#pragma unroll
          for (int j = 0; j < 4; ++j) { const float gt = acc[m][2 * i][j], up = acc[m][2 * i + 1][j]; o[j] = gt * frcp(1.f + __expf(-gt)) * up; }
          *(uint2*)(ACT + (size_t)row * DFF + col) = make_uint2(pack2(o[0], o[1]), pack2(o[2], o[3]));
        }
      }
    }
  }
}

DI void attn_item(const Params& P, int l, int item, char* smem) {
  const int tid = otid(), lane = tid & 63, w = tid >> 6, r = lane & 31, h = lane >> 5;
  bf16_t* sK = (bf16_t*)smem;
  bf16_t* sV = sK + 32 * 72;
  const bf16_t* PROJ = (const bf16_t*)(P.ws + OFF_PROJ);
  bf16_t* CAT = (bf16_t*)(P.ws + OFF_CAT);
  const float2* ROPE = (const float2*)(P.ws + OFF_ROPE);
  const bool ctxq = item >= 1024;
  int b, kvh, qb;
  if (!ctxq) { b = item >> 7; kvh = (item >> 6) & 1; qb = item & 63; }
  else { const int it = item - 1024; b = it >> 4; kvh = (it >> 3) & 1; qb = it & 7; }
  const int q0 = qb * 32, head = kvh * 4 + w;
  const int qp = q0 + r;
  const int qrow = ctxq ? NLAT + b * 256 + qp : b * 2048 + qp;
  bf16x8 qf[4];
  {
    const bf16_t* qptr = PROJ + (size_t)qrow * INW + 512 + head * 64 + 8 * h;
#pragma unroll
    for (int s = 0; s < 4; ++s) qf[s] = *(const bf16x8*)(qptr + 16 * s);
  }
  int i_lo = 0, nwin = 0;
  if (!ctxq) {
    i_lo = q0 < 128 ? (128 - q0) >> 5 : 0;
    int i_hi = (2144 - q0) >> 5; if (i_hi > 8) i_hi = 8;
    nwin = i_hi - i_lo + 1;
  }
  const int nt = nwin + 8;
  const int key = tid >> 3, t8 = tid & 7;
  const int vd = tid >> 2, vc = tid & 3;
  const bf16_t* VT = (const bf16_t*)(P.ws + OFF_VT) + (size_t)(kvh * 64 + vd) * NROW + vc * 8;
  float m_run = P.sink[l * 8 + head] * 1.4426950408889634f;
  float l_run = h == 0 ? 1.f : 0.f;
  f32x16 oacc[2];
#pragma unroll
  for (int i = 0; i < 16; ++i) { oacc[0][i] = 0.f; oacc[1][i] = 0.f; }
  auto tile_row0 = [&](int t) -> size_t {
    const bool kc = t >= nwin;
    const int start = kc ? 32 * (t - nwin) : q0 - 128 + 32 * (i_lo + t);
    return (size_t)((kc ? NLAT + b * 256 : b * 2048) + start);
  };
  auto tile_load = [&](int t, uint4& kr, uint4& vr) {
    if (t < nt) {
      const size_t krow0 = tile_row0(t);
      kr = *(const uint4*)(PROJ + (krow0 + key) * INW + 1024 + kvh * 64 + t8 * 8);
      vr = *(const uint4*)(VT + krow0);
    }
  };
  uint4 kr0, kr1, kr2, kr3, vr0, vr1, vr2, vr3;
  kr0 = kr1 = kr2 = kr3 = vr0 = vr1 = vr2 = vr3 = make_uint4(0u, 0u, 0u, 0u);
  tile_load(0, kr0, vr0); tile_load(1, kr1, vr1); tile_load(2, kr2, vr2); tile_load(3, kr3, vr3);
  constexpr int TILE_E = 32 * 72 + 64 * 40;
  *(uint4*)(sK + key * 72 + t8 * 8) = kr0;
  *(uint4*)(sV + vd * 40 + vc * 8) = vr0;
  tile_load(4, kr0, vr0);
  __syncthreads();
  auto tile_step = [&](int t, uint4& knext, uint4& vnext) {
    const bool kc = t >= nwin;
    const int start = kc ? 32 * (t - nwin) : q0 - 128 + 32 * (i_lo + t);
    if (t + 1 < nt) {
      bf16_t* nb = sK + ((t + 1) & 1) * TILE_E;
      *(uint4*)(nb + key * 72 + t8 * 8) = knext;
      *(uint4*)(nb + 32 * 72 + vd * 40 + vc * 8) = vnext;
      tile_load(t + 5, knext, vnext);
    }
    const bf16_t* sKc = sK + (t & 1) * TILE_E;
    const bf16_t* sVc = sKc + 32 * 72;
    f32x16 sacc;
#pragma unroll
    for (int i = 0; i < 16; ++i) sacc[i] = 0.f;
    {
      bf16x8 kf[4];
#pragma unroll
      for (int s = 0; s < 4; ++s) kf[s] = *(const bf16x8*)(sKc + r * 72 + 16 * s + 8 * h);
      __builtin_amdgcn_s_setprio(1);
#pragma unroll
      for (int s = 0; s < 4; ++s) sacc = MFMA32(kf[s], qf[s], sacc);
      __builtin_amdgcn_s_setprio(0);
    }
    float mx = -INFINITY;
    if (!kc && (start < q0 - 97 || start > q0 + 97)) {
#pragma unroll
      for (int i = 0; i < 16; ++i) {
        const int d = start + crow32(i, h) - qp;
        if (d > 128 || d < -128) sacc[i] = -INFINITY;
      }
    }
#pragma unroll
    for (int i = 0; i < 16; ++i) mx = fmaxf(mx, sacc[i]);
    mx = fmaxf(mx, __shfl_xor(mx, 32));
    const float m_new = fmaxf(m_run, mx);
    const float alpha = __builtin_amdgcn_exp2f(m_run - m_new);
    m_run = m_new;
    float psum = 0.f;
#pragma unroll
    for (int i = 0; i < 16; ++i) { sacc[i] = __builtin_amdgcn_exp2f(sacc[i] - m_new); psum += sacc[i]; }
    l_run = l_run * alpha + psum;
#pragma unroll
    for (int i = 0; i < 16; ++i) { oacc[0][i] *= alpha; oacc[1][i] *= alpha; }
    bf16x8 pf[2];
#pragma unroll
    for (int s2 = 0; s2 < 2; ++s2)
      pf[s2] = __builtin_bit_cast(bf16x8, make_uint4(pack2(sacc[8 * s2 + 0], sacc[8 * s2 + 1]), pack2(sacc[8 * s2 + 2], sacc[8 * s2 + 3]),
                                                      pack2(sacc[8 * s2 + 4], sacc[8 * s2 + 5]), pack2(sacc[8 * s2 + 6], sacc[8 * s2 + 7])));
#pragma unroll
    for (int db = 0; db < 2; ++db)
#pragma unroll
      for (int s2 = 0; s2 < 2; ++s2) {
        const bf16_t* vrow = sVc + (32 * db + r) * 40 + 16 * s2 + 4 * h;
        const uint2 lo = *(const uint2*)(vrow), hi = *(const uint2*)(vrow + 8);
        const bf16x8 vf = __builtin_bit_cast(bf16x8, make_uint4(lo.x, lo.y, hi.x, hi.y));
        oacc[db] = MFMA32(vf, pf[s2], oacc[db]);
      }
    __syncthreads();
  };
  for (int t0 = 0; t0 < nt; t0 += 4) {
    tile_step(t0, kr1, vr1);
    if (t0 + 1 < nt) tile_step(t0 + 1, kr2, vr2);
    if (t0 + 2 < nt) tile_step(t0 + 2, kr3, vr3);
    if (t0 + 3 < nt) tile_step(t0 + 3, kr0, vr0);
  }
  const float ltot = l_run + __shfl_xor(l_run, 32);
  const float inv = frcp(ltot);
  bf16_t* op = CAT + (size_t)qrow * 1024 + 512 + head * 64;
#pragma unroll
  for (int db = 0; db < 2; ++db)
#pragma unroll
    for (int g4 = 0; g4 < 4; ++g4) {
      const int d = 32 * db + 8 * g4 + 4 * h;
      *(uint2*)(op + d) = make_uint2(pack2(oacc[db][4 * g4 + 0] * inv, oacc[db][4 * g4 + 1] * inv), pack2(oacc[db][4 * g4 + 2] * inv, oacc[db][4 * g4 + 3] * inv));
    }
}

template <int HALF>
DI void pool_diffs(const float (&u)[48], bf16_t* sd, int tid, int t0, int Lseq) {
  float s = 0.f;
#pragma unroll
  for (int i = 8 - HALF; i < 8 + HALF; ++i) s += u[i];
#pragma unroll
  for (int tt = 0; tt < 32; ++tt) {
    if (tt > 0) s += u[8 + tt + HALF - 1] - u[8 + tt - HALF - 1];
    const int t = t0 + tt;
    const int cnt = min(t + HALF, Lseq) - max(t - HALF, 0);
    sd[tt * 264 + tid] = f2bf(s * frcp((float)cnt) - u[8 + tt]);
  }
}

DI void pool_item(const Params& P, int l, int item, char* smem) {
  const int tid = otid();
  bf16_t* sd = (bf16_t*)smem;
  const bf16_t* PROJ = (const bf16_t*)(P.ws + OFF_PROJ);
  bf16_t* CAT = (bf16_t*)(P.ws + OFF_CAT);
  const int row0 = item * 32;
  const int seqstart = row0 < NLAT ? (row0 & ~2047) : NLAT + ((row0 - NLAT) & ~255);
  const int Lseq = row0 < NLAT ? 2048 : 256;
  const int t0 = row0 - seqstart;
  const int gi = __builtin_amdgcn_readfirstlane(tid >> 6);
  {
    float u[48];
#pragma unroll
    for (int i = 0; i < 48; ++i) {
      const int t = t0 - 8 + i;
      const int tc = min(max(t, 0), Lseq - 1);
      const float v = bf2f(PROJ[(size_t)(seqstart + tc) * INW + tid]);
      u[i] = (t >= 0 && t < Lseq) ? v : 0.f;
    }
    if (gi == 0) pool_diffs<1>(u, sd, tid, t0, Lseq);
    else if (gi == 1) pool_diffs<2>(u, sd, tid, t0, Lseq);
    else if (gi == 2) pool_diffs<4>(u, sd, tid, t0, Lseq);
    else pool_diffs<8>(u, sd, tid, t0, Lseq);
  }
  const int lane = tid & 63, fr = lane & 15, fq = lane >> 4;
  const bf16_t* wt = (const bf16_t*)(P.ws + OFF_POOLT) + (size_t)(l * 4 + gi) * 4096 + (size_t)fr * 64 + fq * 8;
  bf16x8 bfr[2][4];
#pragma unroll
  for (int ks = 0; ks < 2; ++ks)
#pragma unroll
    for (int n = 0; n < 4; ++n) bfr[ks][n] = *(const bf16x8*)(wt + n * 16 * 64 + ks * 32);
  float4 sc4[4];
#pragma unroll
  for (int n = 0; n < 4; ++n) sc4[n] = *(const float4*)(P.pool_scale + l * 256 + gi * 64 + n * 16 + fq * 4);
  __syncthreads();
  f32x4 acc[2][4];
#pragma unroll
  for (int m = 0; m < 2; ++m)
#pragma unroll
    for (int n = 0; n < 4; ++n) acc[m][n] = f32x4{0.f, 0.f, 0.f, 0.f};
#pragma unroll
  for (int ks = 0; ks < 2; ++ks) {
    bf16x8 af[2];
#pragma unroll
    for (int m = 0; m < 2; ++m) af[m] = *(const bf16x8*)(sd + (m * 16 + fr) * 264 + gi * 64 + ks * 32 + fq * 8);
#pragma unroll
    for (int m = 0; m < 2; ++m)
#pragma unroll
      for (int n = 0; n < 4; ++n) acc[m][n] = MFMA16(bfr[ks][n], af[m], acc[m][n]);
  }
#pragma unroll
  for (int m = 0; m < 2; ++m)
#pragma unroll
    for (int n = 0; n < 4; ++n)
      *(uint2*)(CAT + (size_t)(row0 + m * 16 + fr) * 1024 + gi * 64 + n * 16 + fq * 4) =
          make_uint2(pack2(acc[m][n][0] * sc4[n].x, acc[m][n][1] * sc4[n].y), pack2(acc[m][n][2] * sc4[n].z, acc[m][n][3] * sc4[n].w));
}

DI int chunk_rowbase(int b, int kap) { return kap < 4 ? NLAT + b * 256 + kap * 64 : b * 2048 + (kap - 4) * 64; }

DI void ssm1_item(const Params& P, int l, int item) {
  const int tid = otid(), lane = tid & 63, w = tid >> 6, n = lane & 15, q = lane >> 4;
  const int g = item / 36, dir = (item / 18) & 1, cb = item % 18;
  const int tb = (l * 16 + g) * 2 + dir;
  const int col = cb * 16 + n, b = col / 36, kap = col % 36;
  const bf16_t* up = (const bf16_t*)(P.ws + OFF_PROJ) + (size_t)chunk_rowbase(b, kap) * INW + 256 + g * 16 + 8 * (q & 1) + (size_t)(q >> 1) * INW;
  const bf16_t* ep = (const bf16_t*)(P.ws + OFF_ETAB) + (size_t)tb * 131072 + (size_t)((2 * w) * 16 + n) * 1024 + 8 * q;
  f32x4 acc0 = {0.f, 0.f, 0.f, 0.f}, acc1 = {0.f, 0.f, 0.f, 0.f};
#pragma unroll 8
  for (int ks = 0; ks < 32; ++ks) {
    const bf16x8 bq = *(const bf16x8*)(up + (size_t)(2 * ks) * INW);
    const bf16x8 a0 = *(const bf16x8*)(ep + ks * 32);
    const bf16x8 a1 = *(const bf16x8*)(ep + 16 * 1024 + ks * 32);
    acc0 = MFMA16(a0, bq, acc0);
    acc1 = MFMA16(a1, bq, acc1);
  }
  float* SL = (float*)(P.ws + OFF_SLOC) + ((size_t)((b * 16 + g) * 2 + dir) * 36 + kap) * 128;
  *(float4*)(SL + (2 * w) * 16 + 4 * q) = make_float4(acc0[0], acc0[1], acc0[2], acc0[3]);
  *(float4*)(SL + (2 * w + 1) * 16 + 4 * q) = make_float4(acc1[0], acc1[1], acc1[2], acc1[3]);
}

DI void ssm3_item(const Params& P, int l, int item, char* smem) {
  const int tid = otid(), lane = tid & 63, w = tid >> 6, n = lane & 15, q = lane >> 4;
  const int g = item / 36, dir = (item / 18) & 1, cb = item % 18;
  const int tb = (l * 16 + g) * 2 + dir;
  bf16_t* sst = (bf16_t*)smem;
  bf16_t* sK = sst + 16 * 128;
  char* sU = (char*)(sK + 64 * 256);
  const bf16_t* PROJ = (const bf16_t*)(P.ws + OFF_PROJ);
  struct U8 { uint4 v0, v1, v2, v3, v4, v5, v6, v7; };
  U8 ureg;
  const int bsel = tid >> 6, sp = tid & 63;
  const int bs_raw = (cb * 16) / 36 + bsel;
  const bool scan_on = tid < 128 && bs_raw <= (cb * 16 + 15) / 36;
  const int bs = scan_on ? bs_raw : (cb * 16) / 36;
  float lr[36], li[36];
  {
    const uint4* src = (const uint4*)((const bf16_t*)(P.ws + OFF_KTAB) + (size_t)tb * 16384) + tid;
    uint4 k0 = src[0], k1 = src[256], k2 = src[512], k3 = src[768], k4 = src[1024], k5 = src[1280], k6 = src[1536], k7 = src[1792];
    const float* SL = (const float*)(P.ws + OFF_SLOC) + (size_t)((bs * 16 + g) * 2 + dir) * 36 * 128 + sp;
#pragma unroll
    for (int step = 0; step < 36; ++step) {
      const int kap = dir == 0 ? step : (step < 4 ? 3 - step : 39 - step);
      lr[step] = SL[kap * 128]; li[step] = SL[kap * 128 + 64];
    }
    auto uload = [&](int i, int hf) {
      const int idx = tid + 256 * i, row = idx >> 1, half = idx & 1, nn = row >> 5, off = (row & 31) + 32 * hf;
      const int colg = cb * 16 + nn;
      return *(const uint4*)(PROJ + (size_t)(chunk_rowbase(colg / 36, colg % 36) + off) * INW + 256 + g * 16 + half * 8);
    };
    ureg.v0 = uload(0, 0); ureg.v1 = uload(1, 0); ureg.v2 = uload(2, 0); ureg.v3 = uload(3, 0);
    ureg.v4 = uload(0, 1); ureg.v5 = uload(1, 1); ureg.v6 = uload(2, 1); ureg.v7 = uload(3, 1);
    uint4* d = (uint4*)sK + tid;
    d[0] = k0; d[256] = k1; d[512] = k2; d[768] = k3; d[1024] = k4; d[1280] = k5; d[1536] = k6; d[1792] = k7;
  }
  if (scan_on) {
    const float2 aT = ((const float2*)(P.ws + OFF_AT))[tb * 64 + sp];
    float sr = 0.f, si = 0.f;
#pragma unroll
    for (int step = 0; step < 36; ++step) {
      const int kap = dir == 0 ? step : (step < 4 ? 3 - step : 39 - step);
      const int nloc = bs * 36 + kap - cb * 16;
      if (nloc >= 0 && nloc < 16) { sst[nloc * 128 + sp] = f2bf(sr); sst[nloc * 128 + 64 + sp] = f2bf(si); }
      const float nr = aT.x * sr - aT.y * si + lr[step], ni = aT.x * si + aT.y * sr + li[step];
      sr = nr; si = ni;
    }
  }
  const bf16_t* FT = (const bf16_t*)(P.ws + OFF_FTAB) + (size_t)tb * 131072 + (size_t)n * 128 + 8 * q;
  float* Y = (float*)(P.ws + OFF_YSSM) + (size_t)(dir * 16 + g) * NROW * 16;
  const bf16x8 zero8 = {0, 0, 0, 0, 0, 0, 0, 0};
  {
    const int colg = cb * 16 + n;
    const bool valid = true;
    const int kapc = n;
    const int rowbase = chunk_rowbase(colg / 36, colg % 36);
    f32x4 acc[16];
#pragma unroll
    for (int oi = 0; oi < 16; ++oi) acc[oi] = f32x4{0.f, 0.f, 0.f, 0.f};
    const char* ub = sU + n * 1056 + (q >> 1) * 32 + (q & 1) * 16;
    const char* kb = (const char*)sK + n * 32 + (q & 1) * 16;
    const int wu = __builtin_amdgcn_readfirstlane(w);
    auto half_body = [&](const int hf, const uint4 u0, const uint4 u1, const uint4 u2, const uint4 u3) {
      __syncthreads();
      {
        const int r0 = tid >> 1, h0 = tid & 1;
        char* d = sU + (r0 >> 5) * 1056 + (r0 & 31) * 32 + h0 * 16;
        *(uint4*)(d) = u0; *(uint4*)(d + 4 * 1056) = u1; *(uint4*)(d + 8 * 1056) = u2; *(uint4*)(d + 12 * 1056) = u3;
      }
      __syncthreads();
#pragma unroll
      for (int G = 0; G < 4; ++G) {
        int ks_lo = dir == 0 ? 0 : ((wu + 16 * G) >> 1);
        int ks_hi = dir == 0 ? ((wu + 16 * G + 12) >> 1) : 31;
        ks_lo = max(ks_lo, 16 * hf);
        ks_hi = min(ks_hi, 16 * hf + 15);
#pragma unroll 2
        for (int ks = ks_lo; ks <= ks_hi; ++ks) {
          const bf16x8 bq = *(const bf16x8*)(ub + (ks - 16 * hf) * 64);
          const int off_in = 2 * ks + (q >> 1);
#pragma unroll
          for (int i = 0; i < 4; ++i) {
            const int off_out = w + 16 * G + 4 * i;
            const int tau = dir == 0 ? off_out - off_in : off_in - off_out;
            const int tc = tau < 0 ? 0 : tau;
            bf16x8 a = *(const bf16x8*)(kb + tc * 512);
            if (tau < 0) a = zero8;
            acc[4 * G + i] = MFMA16(a, bq, acc[4 * G + i]);
          }
        }
      }
    };
    half_body(0, ureg.v0, ureg.v1, ureg.v2, ureg.v3);
    half_body(1, ureg.v4, ureg.v5, ureg.v6, ureg.v7);
    bf16x8 sb[4];
#pragma unroll
    for (int k2 = 0; k2 < 4; ++k2) sb[k2] = *(const bf16x8*)(sst + kapc * 128 + k2 * 32 + 8 * q);
#pragma unroll
    for (int oh = 0; oh < 2; ++oh) {
      bf16x8 fa[8][4];
#pragma unroll
      for (int o2 = 0; o2 < 8; ++o2)
#pragma unroll
        for (int k2 = 0; k2 < 4; ++k2) fa[o2][k2] = *(const bf16x8*)(FT + (size_t)(w + 4 * (8 * oh + o2)) * 16 * 128 + k2 * 32);
#pragma unroll
      for (int o2 = 0; o2 < 8; ++o2)
#pragma unroll
        for (int k2 = 0; k2 < 4; ++k2) acc[8 * oh + o2] = MFMA16(fa[o2][k2], sb[k2], acc[8 * oh + o2]);
    }
    if (valid) {
#pragma unroll
      for (int oi = 0; oi < 16; ++oi)
        *(float4*)(Y + (size_t)(rowbase + w + 4 * oi) * 16 + 4 * q) = make_float4(acc[oi][0], acc[oi][1], acc[oi][2], acc[oi][3]);
    }
  }
}

DI void glu_item(const Params& P, int l, int item, char* smem) {
  const int tid = otid(), lane = tid & 63, w = tid >> 6, fr = lane & 15, fq = lane >> 4;
  bf16_t* sG = (bf16_t*)smem;
  const int row0 = item * 64;
  const bf16_t* PROJ = (const bf16_t*)(P.ws + OFF_PROJ);
  const float* Y0 = (const float*)(P.ws + OFF_YSSM);
  const float* Y1 = Y0 + (size_t)NROW * 256;
  bf16_t* CAT = (bf16_t*)(P.ws + OFF_CAT);
#pragma unroll 4
  for (int i = 0; i < 16; ++i) {
    const int rr = tid >> 2, c4 = i * 16 + (tid & 3) * 4;
    const size_t row = (size_t)(row0 + rr);
    const float4 a = *(const float4*)(Y0 + ((size_t)i * NROW + row) * 16 + (tid & 3) * 4), bb = *(const float4*)(Y1 + ((size_t)i * NROW + row) * 16 + (tid & 3) * 4);
    const float4 dd = *(const float4*)(P.ssm_d + l * 256 + c4);
    const uint2 ur = *(const uint2*)(PROJ + row * INW + 256 + c4);
    float y[4] = {dd.x * bflo(ur.x) + a.x + bb.x, dd.y * bfhi(ur.x) + a.y + bb.y, dd.z * bflo(ur.y) + a.z + bb.z, dd.w * bfhi(ur.y) + a.w + bb.w};
#pragma unroll
    for (int j = 0; j < 4; ++j) {
      const float v = y[j];
      const float u = 0.7978845608028654f * (v + 0.044715f * v * v * v);
      const float th = 1.f - 2.f * frcp(1.f + __expf(2.f * u));
      y[j] = 0.5f * v * (1.f + th);
    }
    *(uint2*)(sG + rr * 264 + c4) = make_uint2(pack2(y[0], y[1]), pack2(y[2], y[3]));
  }
  __syncthreads();
  f32x4 acc[4][4];
#pragma unroll
  for (int m = 0; m < 4; ++m)
#pragma unroll
    for (int nn = 0; nn < 4; ++nn) acc[m][nn] = f32x4{0.f, 0.f, 0.f, 0.f};
  const bf16_t* GT = (const bf16_t*)(P.ws + OFF_GLUT) + (size_t)l * 65536 + (size_t)(w * 64 + fr) * 256 + fq * 8;
#pragma unroll 4
  for (int ks = 0; ks < 8; ++ks) {
    bf16x8 af[4], bfr[4];
#pragma unroll
    for (int m = 0; m < 4; ++m) af[m] = *(const bf16x8*)(sG + (m * 16 + fr) * 264 + ks * 32 + fq * 8);
#pragma unroll
    for (int nn = 0; nn < 4; ++nn) bfr[nn] = *(const bf16x8*)(GT + (size_t)nn * 16 * 256 + ks * 32);
#pragma unroll
    for (int m = 0; m < 4; ++m)
#pragma unroll
      for (int nn = 0; nn < 4; ++nn) acc[m][nn] = MFMA16(bfr[nn], af[m], acc[m][nn]);
  }
#pragma unroll
  for (int m = 0; m < 4; ++m) {
    const int rr = m * 16 + fr;
#pragma unroll
    for (int nn = 0; nn < 4; ++nn) {
      const int col = w * 64 + nn * 16 + fq * 4;
      const float4 gb = *(const float4*)(P.glu_b + l * 256 + col);
      const uint2 gr = *(const uint2*)(sG + rr * 264 + col);
      const float z0 = acc[m][nn][0] + gb.x, z1 = acc[m][nn][1] + gb.y, z2 = acc[m][nn][2] + gb.z, z3 = acc[m][nn][3] + gb.w;
      const float o0 = bflo(gr.x) * frcp(1.f + __expf(-z0)), o1 = bfhi(gr.x) * frcp(1.f + __expf(-z1));
      const float o2 = bflo(gr.y) * frcp(1.f + __expf(-z2)), o3 = bfhi(gr.y) * frcp(1.f + __expf(-z3));
      *(uint2*)(CAT + (size_t)(row0 + rr) * 1024 + 256 + col) = make_uint2(pack2(o0, o1), pack2(o2, o3));
    }
  }
}

#define XB_TMO      128
#define XB_XCNT(j)  (256  + 64 * (j))
#define XB_XSUB(j)  (1280 + 64 * (j))
#define XB_XGEN(j)  (2304 + 64 * (j))
#define XB_TOP      3328
#define XB_TOPGEN   3392
#define XCD_BAR_WORDS 3456
#define XB_SPIN_CAP (1u << 21)
#define LAS __attribute__((address_space(3)))

__device__ __forceinline__ unsigned xb_ld(unsigned* p)              { return __hip_atomic_load(p, __ATOMIC_RELAXED, __HIP_MEMORY_SCOPE_AGENT); }
__device__ __forceinline__ unsigned xb_add(unsigned* p, unsigned v) { return __hip_atomic_fetch_add(p, v, __ATOMIC_RELAXED, __HIP_MEMORY_SCOPE_AGENT); }
__device__ __forceinline__ unsigned xb_xcc_id() { return (unsigned)__builtin_amdgcn_s_getreg((3 << 11) | 20) & 0xFu; }
#define XB_SPIN(cond, bar) do { unsigned _sp = 0; while (cond) { __builtin_amdgcn_s_sleep(1); \
    if ((++_sp & 255u) == 0u) { if (xb_ld(&(bar)[XB_TMO])) break; if (_sp > XB_SPIN_CAP) { atomicAdd(&(bar)[XB_TMO], 1u); break; } } } } while (0)

struct XcdBarrier {
    unsigned* bar; unsigned x;
    volatile LAS unsigned* st;
};

__device__ __forceinline__ XcdBarrier xcd_barrier_post(unsigned* bar, volatile LAS unsigned* st) {
    XcdBarrier b; b.bar = bar; b.x = xb_xcc_id(); b.st = st;
    if (threadIdx.x == 0) (void)xb_add(&bar[XB_XCNT(b.x)], 1u);
    return b;
}
__device__ __forceinline__ void xcd_barrier_complete(unsigned* bar, unsigned x, unsigned& nloc, unsigned& nx) {
    const unsigned G = gridDim.x * gridDim.y * gridDim.z;
    unsigned sum, cnt, mine, sp = 0u;
    for (;;) {
        sum = 0u; cnt = 0u; mine = 0u;
#pragma unroll
        for (unsigned j = 0; j < 16; ++j) { const unsigned c = xb_ld(&bar[XB_XCNT(j)]); sum += c; cnt += (c > 0u) ? 1u : 0u; mine = (j == x) ? c : mine; }
        if (sum == G) break;
        __builtin_amdgcn_s_sleep(1);
        if ((++sp & 255u) == 0u) { if (xb_ld(&bar[XB_TMO])) break; if (sp > XB_SPIN_CAP) { atomicAdd(&bar[XB_TMO], 1u); break; } }
    }
    nloc = mine > 0u ? mine : 1u; nx = cnt > 0u ? cnt : 1u;
}

__device__ __forceinline__ void xcd_barrier(const XcdBarrier& b) {
    asm volatile("s_waitcnt vmcnt(0)" ::: "memory");
    __syncthreads();
    if (threadIdx.x == 0) {
        unsigned* bar = b.bar;
        __builtin_amdgcn_s_waitcnt(0);
        unsigned nloc = b.st[0], nx = b.st[1];
        if (nloc == 0u) { xcd_barrier_complete(bar, b.x, nloc, nx); b.st[0] = nloc; b.st[1] = nx; }
        const unsigned old = xb_add(&bar[XB_XSUB(b.x)], 1u);
        const unsigned gen = old / nloc;
        if (old + 1u == (gen + 1u) * nloc) {
            __builtin_amdgcn_fence(__ATOMIC_RELEASE, "agent");
            asm volatile("s_waitcnt vmcnt(0)" ::: "memory");
            const unsigned og = xb_add(&bar[XB_TOP], 1u);
            const unsigned tg = og / nx;
            if (og + 1u == (tg + 1u) * nx) xb_add(&bar[XB_TOPGEN], 1u);
            else XB_SPIN(xb_ld(&bar[XB_TOPGEN]) == tg, bar);
            __builtin_amdgcn_fence(__ATOMIC_ACQUIRE, "agent");
            xb_add(&bar[XB_XGEN(b.x)], 1u);
            asm volatile("s_waitcnt vmcnt(0)" ::: "memory");
        } else {
            XB_SPIN(xb_ld(&bar[XB_XGEN(b.x)]) == gen, bar);
            __builtin_amdgcn_fence(__ATOMIC_ACQUIRE, "agent");
            asm volatile("s_waitcnt vmcnt(0)" ::: "memory");
        }
    }
    __syncthreads();
}


constexpr int NPHASES = 1 + 4 * 9;

template <int SP>
DI void run_sub(const Params& P, int l, char* smem) {
  const bool last = l == 3;
  const int rows_act = last ? NLAT : NROW;
  if constexpr (SP == 9) { ph_prologue(P, smem); }
  else if constexpr (SP == 0) { ph_norm(P, l, 0, NROW); }
  else if constexpr (SP == 1) { ph_gemm<0>(P, l, (const bf16_t*)(P.ws + OFF_H), (const bf16_t*)(P.ws + OFF_WIN) + l * W_IN_E, NROW, INW, DM, 0, false, smem); }
  else if constexpr (SP == 2) {
    const int nattn = last ? 1024 : 1152;
    const int total = nattn + 576;
    for (int it = blockIdx.x; it < total; it += gridDim.x) {
      if (it < nattn) attn_item(P, l, it, smem);
      else ssm1_item(P, l, it - nattn);
      __syncthreads();
    }
  }
  else if constexpr (SP == 3) {
    const int npool = rows_act / 32;
    for (int it = blockIdx.x; it < 576 + npool; it += gridDim.x) {
      if (it < 576) ssm3_item(P, l, it, smem);
      else pool_item(P, l, it - 576, smem);
      __syncthreads();
    }
  }
  else if constexpr (SP == 4) { for (int it = blockIdx.x; it < rows_act / 64; it += gridDim.x) { glu_item(P, l, it, smem); __syncthreads(); } }
  else if constexpr (SP == 5) { ph_gemm<1>(P, l, (const bf16_t*)(P.ws + OFF_CAT), (const bf16_t*)(P.ws + OFF_WOUT) + l * W_OUT_E, rows_act, DM, DM, 2, false, smem); }
  else if constexpr (SP == 6) { ph_norm(P, l, 1, rows_act); }
  else if constexpr (SP == 7) { ph_gemm<2>(P, l, (const bf16_t*)(P.ws + OFF_H), (const bf16_t*)(P.ws + OFF_WGU) + l * W_GU_E, rows_act, 2 * DFF, DM, 0, false, smem); }
  else if constexpr (SP == 8) { ph_gemm<1>(P, l, (const bf16_t*)(P.ws + OFF_ACT), (const bf16_t*)(P.ws + OFF_WD) + l * W_D_E, rows_act, DM, DFF, 5, last, smem); }
}

DI void run_phase(const Params& P, int ph, char* smem) {
  if (ph == 0) { run_sub<9>(P, 0, smem); return; }
  const int l = (ph - 1) / 9, sp = (ph - 1) % 9;
  switch (sp) {
    case 0: run_sub<0>(P, l, smem); break;
    case 1: run_sub<1>(P, l, smem); break;
    case 2: run_sub<2>(P, l, smem); break;
    case 3: run_sub<3>(P, l, smem); break;
    case 4: run_sub<4>(P, l, smem); break;
    case 5: run_sub<5>(P, l, smem); break;
    case 6: run_sub<6>(P, l, smem); break;
    case 7: run_sub<7>(P, l, smem); break;
    case 8: run_sub<8>(P, l, smem); break;
  }
}

extern __shared__ __attribute__((aligned(16))) char dyn_smem[];

#if !MEGA
template <int SP> __global__ void __launch_bounds__(NTHREADS, 2) k_sub(Params P, int l) { run_sub<SP>(P, l, dyn_smem); }
#endif

#if MEGA
__global__ void __launch_bounds__(NTHREADS, 2) k_mega(Params P) {
  cg::grid_group grid = cg::this_grid();
  uint4* xbw = (uint4*)(dyn_smem + LDS_PHASE);
  if (threadIdx.x == 0) *xbw = make_uint4(0u, 0u, 0u, 0u);
  __syncthreads();
  XcdBarrier xb = xcd_barrier_post((unsigned*)(P.ws + OFF_BAR), (volatile LAS unsigned*)xbw);
  run_sub<9>(P, 0, dyn_smem);
  if (P.ws == nullptr) grid.sync();
  xcd_barrier(xb);
#pragma unroll 1
  for (int l = 0; l < 4; ++l) {
    run_sub<0>(P, l, dyn_smem); xcd_barrier(xb);
    run_sub<1>(P, l, dyn_smem); xcd_barrier(xb);
    run_sub<2>(P, l, dyn_smem); xcd_barrier(xb);
    run_sub<3>(P, l, dyn_smem); xcd_barrier(xb);
    run_sub<4>(P, l, dyn_smem); xcd_barrier(xb);
    run_sub<5>(P, l, dyn_smem); xcd_barrier(xb);
    run_sub<6>(P, l, dyn_smem); xcd_barrier(xb);
    run_sub<7>(P, l, dyn_smem); xcd_barrier(xb);
    run_sub<8>(P, l, dyn_smem);
    if (l < 3) xcd_barrier(xb);
  }
}
#define OCC_KERNEL k_mega
#else
#define OCC_KERNEL k_sub<1>
#endif

extern "C" void kernel_launch(void* const* d_in, const int* in_sizes, int n_in, void* d_out, int out_size, void* d_ws, size_t ws_size,
                              hipStream_t stream) {
  if (n_in < 28 || ws_size < WS_END) { fprintf(stderr, "kernel_launch: bad inputs (n_in %d, ws %zu < %zu)\n", n_in, ws_size, (size_t)WS_END); return; }
  Params P{};
  const float** pp = (const float**)&P;
  for (int i = 0; i < 28; ++i) pp[i] = (const float*)d_in[i];
  P.out = (float*)d_out;
  P.ws = (char*)d_ws;
  static int grid_blocks = 0;
  if (!grid_blocks) {
    int dev = 0, cus = 0, per_cu = 0;
    hipGetDevice(&dev);
    hipDeviceGetAttribute(&cus, hipDeviceAttributeMultiprocessorCount, dev);
#if MEGA
    hipFuncSetAttribute((const void*)k_mega, hipFuncAttributeMaxDynamicSharedMemorySize, LDS_BYTES);
#endif
#if !MEGA
    hipFuncSetAttribute((const void*)k_sub<0>, hipFuncAttributeMaxDynamicSharedMemorySize, LDS_BYTES);
    hipFuncSetAttribute((const void*)k_sub<1>, hipFuncAttributeMaxDynamicSharedMemorySize, LDS_BYTES);
    hipFuncSetAttribute((const void*)k_sub<2>, hipFuncAttributeMaxDynamicSharedMemorySize, LDS_BYTES);
    hipFuncSetAttribute((const void*)k_sub<3>, hipFuncAttributeMaxDynamicSharedMemorySize, LDS_BYTES);
    hipFuncSetAttribute((const void*)k_sub<4>, hipFuncAttributeMaxDynamicSharedMemorySize, LDS_BYTES);
    hipFuncSetAttribute((const void*)k_sub<5>, hipFuncAttributeMaxDynamicSharedMemorySize, LDS_BYTES);
    hipFuncSetAttribute((const void*)k_sub<6>, hipFuncAttributeMaxDynamicSharedMemorySize, LDS_BYTES);
    hipFuncSetAttribute((const void*)k_sub<7>, hipFuncAttributeMaxDynamicSharedMemorySize, LDS_BYTES);
    hipFuncSetAttribute((const void*)k_sub<8>, hipFuncAttributeMaxDynamicSharedMemorySize, LDS_BYTES);
    hipFuncSetAttribute((const void*)k_sub<9>, hipFuncAttributeMaxDynamicSharedMemorySize, LDS_BYTES);
#endif
    hipOccupancyMaxActiveBlocksPerMultiprocessor(&per_cu, (const void*)OCC_KERNEL, NTHREADS, LDS_BYTES);
    if (per_cu < 1) per_cu = 1;
    if (per_cu > 2) per_cu = 2;
    grid_blocks = cus * per_cu;
  }
#if MEGA
  hipMemsetAsync((char*)d_ws + OFF_BAR, 0, BAR_BYTES, stream);
  void* args[] = {&P};
  hipError_t e = hipLaunchCooperativeKernel((const void*)k_mega, dim3(grid_blocks), dim3(NTHREADS), args, LDS_BYTES, stream);
  if (e != hipSuccess) fprintf(stderr, "cooperative launch failed: %s (grid %d)\n", hipGetErrorString(e), grid_blocks);
#else
  const dim3 G(grid_blocks), T(NTHREADS);
  k_sub<9><<<G, T, LDS_BYTES, stream>>>(P, 0);
  for (int l = 0; l < 4; ++l) {
    k_sub<0><<<G, T, LDS_BYTES, stream>>>(P, l);
    k_sub<1><<<G, T, LDS_BYTES, stream>>>(P, l);
    k_sub<2><<<G, T, LDS_BYTES, stream>>>(P, l);
    k_sub<3><<<G, T, LDS_BYTES, stream>>>(P, l);
    k_sub<4><<<G, T, LDS_BYTES, stream>>>(P, l);
    k_sub<5><<<G, T, LDS_BYTES, stream>>>(P, l);
    k_sub<6><<<G, T, LDS_BYTES, stream>>>(P, l);
    k_sub<7><<<G, T, LDS_BYTES, stream>>>(P, l);
    k_sub<8><<<G, T, LDS_BYTES, stream>>>(P, l);
  }
#endif
}
```

```cpp
#include <hip/hip_runtime.h>
#include <hip/hip_cooperative_groups.h>
#include <stdint.h>
#include <stdio.h>
namespace cg = cooperative_groups;

#ifndef MEGA
#define MEGA 1
#endif

typedef unsigned short bf16_t;
using bf16x8 = __attribute__((ext_vector_type(8))) short;
using f32x4 = __attribute__((ext_vector_type(4))) float;
using f32x16 = __attribute__((ext_vector_type(16))) float;
#define DI __device__ __forceinline__
#define MFMA16(a, b, c) __builtin_amdgcn_mfma_f32_16x16x32_bf16((a), (b), (c), 0, 0, 0)
#define MFMA32(a, b, c) __builtin_amdgcn_mfma_f32_32x32x16_bf16((a), (b), (c), 0, 0, 0)

constexpr int NLAT = 16384, NROW = 18432, DM = 1024, INW = 1280, DFF = 2816;
constexpr int LDS_PHASE = 65536;
constexpr int LDS_BYTES = LDS_PHASE + 16;
constexpr int NTHREADS = 256;

constexpr size_t OFF_XRES = 0;
constexpr size_t OFF_H = OFF_XRES + (size_t)NROW * DM * 4;
constexpr size_t OFF_UNI = OFF_H + (size_t)NROW * DM * 2;
constexpr size_t OFF_PROJ = OFF_UNI;
constexpr size_t OFF_CAT = OFF_PROJ + (size_t)NROW * INW * 2;
constexpr size_t OFF_YSSM = OFF_CAT + (size_t)NROW * DM * 2;
constexpr size_t OFF_VT = OFF_YSSM;
constexpr size_t OFF_ACT = OFF_UNI;
constexpr size_t OFF_W = OFF_YSSM + (size_t)2 * NROW * 256 * 4;
constexpr size_t W_IN_E = (size_t)INW * DM, W_OUT_E = (size_t)DM * DM, W_GU_E = (size_t)2 * DFF * DM, W_D_E = (size_t)DM * DFF, W_GLU_E = 65536;
constexpr size_t OFF_WIN = OFF_W;
constexpr size_t OFF_WOUT = OFF_WIN + 4 * W_IN_E * 2;
constexpr size_t OFF_WGU = OFF_WOUT + 4 * W_OUT_E * 2;
constexpr size_t OFF_WD = OFF_WGU + 4 * W_GU_E * 2;
constexpr size_t OFF_GLUT = OFF_WD + 4 * W_D_E * 2;
constexpr size_t OFF_MOD = OFF_GLUT + 4 * W_GLU_E * 2;
constexpr size_t OFF_KTAB = OFF_MOD + (size_t)4 * 9 * 6144 * 4;
constexpr size_t OFF_ETAB = OFF_KTAB + (size_t)128 * 16384 * 2;
constexpr size_t OFF_FTAB = OFF_ETAB + (size_t)128 * 131072 * 2;
constexpr size_t OFF_AT = OFF_FTAB + (size_t)128 * 131072 * 2;
constexpr size_t OFF_ROPE = OFF_AT + (size_t)128 * 64 * 8;
constexpr size_t OFF_BAR = OFF_ROPE + 64 * 16 * 8;
constexpr size_t BAR_BYTES = 3456 * 4;
constexpr size_t OFF_POOLT = OFF_BAR + BAR_BYTES;
constexpr size_t WS_END = OFF_POOLT + (size_t)4 * 4 * 64 * 64 * 2;
constexpr size_t OFF_SLOC = OFF_H;

struct Params {
  const float *x, *c, *ctx, *c_ctx, *w_mod, *b_mod, *norm_mix, *norm_ffn, *w_in, *w_out, *pool_w, *pool_scale;
  const float *a_re, *a_im, *log_dt, *b_re, *b_im, *c_re, *c_im, *ssm_d, *glu_w, *glu_b, *q_norm, *k_norm, *sink;
  const float *w_gate, *w_up, *w_down;
  float* out;
  char* ws;
};

DI unsigned short f2bf(float x) { unsigned u = __float_as_uint(x); u += 0x7fffu + ((u >> 16) & 1u); return (unsigned short)(u >> 16); }
DI float bf2f(unsigned short h) { return __uint_as_float(((unsigned)h) << 16); }
DI unsigned pack2(float a, float b) { unsigned r; asm("v_cvt_pk_bf16_f32 %0, %1, %2\n\ts_nop 1" : "=v"(r) : "v"(a), "v"(b)); return r; }
DI float bflo(unsigned u) { return __uint_as_float(u << 16); }
DI float bfhi(unsigned u) { return __uint_as_float(u & 0xffff0000u); }
DI int otid() { int t = threadIdx.x; asm volatile("" : "+v"(t)); return t; }
DI float frcp(float x) { return __builtin_amdgcn_rcpf(x); }
DI int crow32(int i, int h) { return (i & 3) + 8 * (i >> 2) + 4 * h; }

DI void sincos_d(double x, double* sn, double* cs) {
  const double kd = rint(x * 0.6366197723675814);
  double r = fma(-kd, 1.5707963267948966, x);
  r = fma(-kd, 6.123233995736766e-17, r);
  const int k = ((int)kd) & 3;
  const double r2 = r * r;
  const double sp = r + r * r2 * (-1.0 / 6 + r2 * (1.0 / 120 + r2 * (-1.0 / 5040 + r2 * (1.0 / 362880 + r2 * (-1.0 / 39916800 + r2 * (1.0 / 6227020800.0 + r2 * (-1.0 / 1307674368000.0)))))));
  const double cp = 1.0 + r2 * (-0.5 + r2 * (1.0 / 24 + r2 * (-1.0 / 720 + r2 * (1.0 / 40320 + r2 * (-1.0 / 3628800 + r2 * (1.0 / 479001600 + r2 * (-1.0 / 87178291200.0)))))));
  const double s0 = (k & 1) ? cp : sp, c0 = (k & 1) ? sp : cp;
  *sn = (k & 2) ? -s0 : s0;
  *cs = ((k + 1) & 2) ? -c0 : c0;
}
DI void pro_ssm(const Params& P, int item, char* smem) {
  const int tid = otid();
  const int tb = item >> 2, qt = item & 3;
  const int l = tb >> 5, g = (tb >> 1) & 15, dir = tb & 1;
  const int ig = (l * 2 + dir) * 16 + g;
  float2* apow = (float2*)smem;
  float2* bbar = apow + 65 * 64;
  float2* cm = bbar + 64 * 16;
  const double dt = exp((double)P.log_dt[ig]);
  {
    const int p = tid & 63;
    const double lre = fmin((double)P.a_re[ig * 64 + p], -1e-4), lim = (double)P.a_im[ig * 64 + p];
#pragma unroll 1
    for (int e = tid >> 6; e <= 64; e += 4) {
      double mag = exp(lre * dt * (double)e), sn, cs;
      sincos_d(lim * dt * (double)e, &sn, &cs);
      apow[e * 64 + p] = make_float2((float)(mag * cs), (float)(mag * sn));
    }
  }
#pragma unroll 1
  for (int i = 0; i < 4; ++i) {
    const int idx = tid + 256 * i, p = idx >> 4, c = idx & 15;
    const double lre = fmin((double)P.a_re[ig * 64 + p], -1e-4), lim = (double)P.a_im[ig * 64 + p];
    double mag = exp(lre * dt), sn, cs;
    sincos_d(lim * dt, &sn, &cs);
    const double nre = mag * cs - 1.0, nim = mag * sn;
    const double den = lre * lre + lim * lim;
    const double cre = (nre * lre + nim * lim) / den, cim = (nim * lre - nre * lim) / den;
    const double bre = (double)P.b_re[(size_t)(ig * 64 + p) * 16 + c], bim = (double)P.b_im[(size_t)(ig * 64 + p) * 16 + c];
    bbar[p * 16 + c] = make_float2((float)(cre * bre - cim * bim), (float)(cre * bim + cim * bre));
    const int c2 = idx >> 6, p2 = idx & 63;
    cm[c2 * 64 + p2] = make_float2(P.c_re[(size_t)(ig * 16 + c2) * 64 + p2], P.c_im[(size_t)(ig * 16 + c2) * 64 + p2]);
  }
  __syncthreads();
  bf16_t* KT = (bf16_t*)(P.ws + OFF_KTAB) + (size_t)tb * 16384;
  bf16_t* ET = (bf16_t*)(P.ws + OFF_ETAB) + (size_t)tb * 131072;
  bf16_t* FT = (bf16_t*)(P.ws + OFF_FTAB) + (size_t)tb * 131072;
  {
    const int ci = tid & 15, co = tid >> 4;
#pragma unroll 1
    for (int tt = 0; tt < 16; ++tt) {
      const int tau = qt * 16 + tt;
      float acc = 0.f;
#pragma unroll 4
      for (int p = 0; p < 64; ++p) {
        const float2 cc = cm[co * 64 + p], aa = apow[tau * 64 + p], bb = bbar[p * 16 + ci];
        const float xr = cc.x * aa.x - cc.y * aa.y, xi = cc.x * aa.y + cc.y * aa.x;
        acc += xr * bb.x - xi * bb.y;
      }
      KT[tau * 256 + co * 16 + ci] = f2bf(acc);
    }
  }
  {
    const int c = tid & 15, ol = tid >> 4, off = qt * 16 + ol;
    const int e = dir == 0 ? 63 - off : off;
#pragma unroll 2
    for (int p = 0; p < 64; ++p) {
      const float2 aa = apow[e * 64 + p], bb = bbar[p * 16 + c];
      ET[(size_t)p * 1024 + off * 16 + c] = f2bf(aa.x * bb.x - aa.y * bb.y);
      ET[(size_t)(64 + p) * 1024 + off * 16 + c] = f2bf(aa.x * bb.y + aa.y * bb.x);
    }
  }
  {
    const int col = tid & 127, half = tid >> 7, p = col & 63, part = col >> 6;
#pragma unroll 2
    for (int rr = 0; rr < 128; ++rr) {
      const int rowl = half * 128 + rr, off = qt * 16 + (rowl >> 4), co = rowl & 15;
      const int e = dir == 0 ? off + 1 : 64 - off;
      const float2 cc = cm[co * 64 + p], aa = apow[e * 64 + p];
      const float vr = cc.x * aa.x - cc.y * aa.y, vi = cc.x * aa.y + cc.y * aa.x;
      FT[(size_t)(off * 16 + co) * 128 + col] = f2bf(part == 0 ? vr : -vi);
    }
  }
  if (qt == 0 && tid < 64) ((float2*)(P.ws + OFF_AT))[tb * 64 + tid] = apow[64 * 64 + tid];
}

DI void pro_mod(const Params& P, int item, char* smem) {
  const int tid = otid();
  const int l = item / 96, n0 = (item % 96) * 64;
  float* sl = (float*)smem;
  float* red = sl;
  for (int i = tid; i < 9 * 1024; i += 256) {
    const int r = i >> 10, k = i & 1023;
    const float v = r < 8 ? P.c[r * 1024 + k] : P.c_ctx[k];
    sl[i] = v / (1.f + __expf(-v));
  }
  __syncthreads();
  const int kq = tid >> 4, cq = tid & 15;
  float acc[9][4];
#pragma unroll
  for (int r = 0; r < 9; ++r) { acc[r][0] = acc[r][1] = acc[r][2] = acc[r][3] = 0.f; }
  const float* wp = P.w_mod + (size_t)l * 1024 * 6144 + n0 + cq * 4;
#pragma unroll 4
  for (int i = 0; i < 64; ++i) {
    const int k = kq + 16 * i;
    const float4 w = *(const float4*)(wp + (size_t)k * 6144);
#pragma unroll
    for (int r = 0; r < 9; ++r) {
      const float s = sl[r * 1024 + k];
      acc[r][0] += s * w.x; acc[r][1] += s * w.y; acc[r][2] += s * w.z; acc[r][3] += s * w.w;
    }
  }
  __syncthreads();
#pragma unroll
  for (int r = 0; r < 9; ++r)
#pragma unroll
    for (int j = 0; j < 4; ++j) red[(kq * 9 + r) * 64 + cq * 4 + j] = acc[r][j];
  __syncthreads();
  float* MOD = (float*)(P.ws + OFF_MOD);
  for (int o = tid; o < 9 * 64; o += 256) {
    const int r = o >> 6, cc = o & 63;
    float s = P.b_mod[l * 6144 + n0 + cc];
    for (int q = 0; q < 16; ++q) s += red[(q * 9 + r) * 64 + cc];
    MOD[(size_t)(l * 9 + r) * 6144 + n0 + cc] = s;
  }
}

DI void pro_poolw(const Params& P, int item) {
  const int tid = otid();
  bf16_t* PT = (bf16_t*)(P.ws + OFF_POOLT);
  float v[16];
#pragma unroll
  for (int i = 0; i < 16; ++i) {
    const int e = item * 4096 + i * 256 + tid, lg = e >> 12, o = (e >> 6) & 63, c = e & 63;
    v[i] = P.pool_w[(size_t)lg * 4096 + c * 64 + o];
  }
#pragma unroll
  for (int i = 0; i < 16; ++i) PT[item * 4096 + i * 256 + tid] = f2bf(v[i]);
}

DI void pro_rope(const Params& P) {
  float2* R = (float2*)(P.ws + OFF_ROPE);
  for (int i = otid(); i < 1024; i += 256) {
    const int v = i >> 4, f = i & 15;
    const double inv = exp(-(double)f * (9.210340371976184 / 16.0));
    double sn, cs;
    sincos_d((double)v * inv, &sn, &cs);
    R[i] = make_float2((float)cs, (float)sn);
  }
}

DI void pro_transpose(const Params& P, int idx, char* smem) {
  const int tid = otid();
  const int l = idx / 2704;
  int r = idx % 2704;
  const float* src; bf16_t* dst; int K, N, kt, nt, rs = 16, ro = 0;
  if (r < 320) { src = P.w_in + (size_t)l * 1024 * 1280; dst = (bf16_t*)(P.ws + OFF_WIN) + l * W_IN_E; K = 1024; N = 1280; kt = r / 20; nt = r % 20; }
  else if (r < 576) { r -= 320; src = P.w_out + (size_t)l * 1024 * 1024; dst = (bf16_t*)(P.ws + OFF_WOUT) + l * W_OUT_E; K = 1024; N = 1024; kt = r / 16; nt = r % 16; }
  else if (r < 1280) { r -= 576; src = P.w_gate + (size_t)l * 1024 * 2816; dst = (bf16_t*)(P.ws + OFF_WGU) + l * W_GU_E; K = 1024; N = 2816; kt = r / 44; nt = r % 44; rs = 32; }
  else if (r < 1984) { r -= 1280; src = P.w_up + (size_t)l * 1024 * 2816; dst = (bf16_t*)(P.ws + OFF_WGU) + l * W_GU_E; K = 1024; N = 2816; kt = r / 44; nt = r % 44; rs = 32; ro = 16; }
  else if (r < 2688) { r -= 1984; src = P.w_down + (size_t)l * 2816 * 1024; dst = (bf16_t*)(P.ws + OFF_WD) + l * W_D_E; K = 2816; N = 1024; kt = r / 16; nt = r % 16; }
  else { r -= 2688; src = P.glu_w + (size_t)l * 65536; dst = (bf16_t*)(P.ws + OFF_GLUT) + l * W_GLU_E; K = 256; N = 256; kt = r / 4; nt = r % 4; }
  float* tile = (float*)smem;
  const int k0 = kt * 64, n0 = nt * 64;
  {
    const int kr = tid >> 4, nc = (tid & 15) * 4;
#pragma unroll
    for (int i = 0; i < 4; ++i) {
      const float4 v = *(const float4*)(src + (size_t)(k0 + kr + 16 * i) * N + n0 + nc);
      tile[(nc + 0) * 65 + kr + 16 * i] = v.x; tile[(nc + 1) * 65 + kr + 16 * i] = v.y;
      tile[(nc + 2) * 65 + kr + 16 * i] = v.z; tile[(nc + 3) * 65 + kr + 16 * i] = v.w;
    }
  }
  __syncthreads();
  {
    const int n = tid >> 2, kq = (tid & 3) * 16;
    const int ng = n0 + n;
    const int drow = (ng >> 4) * rs + (ng & 15) + ro;
    unsigned o[8];
#pragma unroll
    for (int j = 0; j < 8; ++j) o[j] = pack2(tile[n * 65 + kq + 2 * j], tile[n * 65 + kq + 2 * j + 1]);
    uint4* d = (uint4*)(dst + (size_t)drow * K + k0 + kq);
    d[0] = make_uint4(o[0], o[1], o[2], o[3]);
    d[1] = make_uint4(o[4], o[5], o[6], o[7]);
  }
}

DI void pro_copy(const Params& P, int item) {
  const int tid = otid();
  const size_t base = (size_t)item * 4096;
  float4* dst = (float4*)(P.ws + OFF_XRES);
#pragma unroll
  for (int i = 0; i < 4; ++i) {
    const size_t e = base + (size_t)(tid + 256 * i) * 4;
    const float4 v = e < (size_t)NLAT * DM ? *(const float4*)(P.x + e) : *(const float4*)(P.ctx + (e - (size_t)NLAT * DM));
    dst[e >> 2] = v;
  }
}

constexpr int PRO_SSM = 512, PRO_MOD = 384, PRO_TR = 10816, PRO_PW = 16;
constexpr int PRO_ITEMS = PRO_SSM + PRO_MOD + 1 + PRO_PW + PRO_TR;

DI void ph_prologue(const Params& P, char* smem) {
  for (int item = blockIdx.x; item < PRO_ITEMS; item += gridDim.x) {
    if (item < PRO_SSM) pro_ssm(P, item, smem);
    else if (item < PRO_SSM + PRO_MOD) pro_mod(P, item - PRO_SSM, smem);
    else if (item < PRO_SSM + PRO_MOD + 1) pro_rope(P);
    else if (item < PRO_SSM + PRO_MOD + 1 + PRO_PW) pro_poolw(P, item - (PRO_SSM + PRO_MOD + 1));
    else pro_transpose(P, item - (PRO_SSM + PRO_MOD + 1 + PRO_PW), smem);
    __syncthreads();
  }
}

DI void ph_norm(const Params& P, int l, int which, int nrows) {
  const bool seed = (l == 0 && which == 0);
  const int tid = otid(), lane = tid & 63, w = tid >> 6;
  float* XR = (float*)(P.ws + OFF_XRES);
  bf16_t* H = (bf16_t*)(P.ws + OFF_H);
  const float* MOD = (const float*)(P.ws + OFF_MOD);
  const float* g = (which ? P.norm_ffn : P.norm_mix) + l * 1024;
  for (int row = blockIdx.x * 4 + w; row < nrows; row += gridDim.x * 4) {
    const float4* xr = seed ? (const float4*)(row < NLAT ? P.x + (size_t)row * 1024 : P.ctx + (size_t)(row - NLAT) * 1024) : (const float4*)(XR + (size_t)row * 1024);
    float4 v[4];
    float ss = 0.f;
#pragma unroll
    for (int i = 0; i < 4; ++i) { v[i] = xr[lane + 64 * i]; ss += v[i].x * v[i].x + v[i].y * v[i].y + v[i].z * v[i].z + v[i].w * v[i].w; }
#pragma unroll
    for (int m = 32; m >= 1; m >>= 1) ss += __shfl_xor(ss, m);
    const float rstd = rsqrtf(ss * (1.f / 1024.f) + 1e-6f);
    if (seed) {
#pragma unroll
      for (int i = 0; i < 4; ++i) ((float4*)(XR + (size_t)row * 1024))[lane + 64 * i] = v[i];
    }
    const int mr = row < NLAT ? (row >> 11) : 8;
    const float* mp = MOD + (size_t)(l * 9 + mr) * 6144;
    const float* sh = mp + (which ? 3 : 0) * 1024;
    const float* sc = mp + (which ? 4 : 1) * 1024;
#pragma unroll
    for (int i = 0; i < 4; ++i) {
      const int col = (lane + 64 * i) * 4;
      const float4 gg = *(const float4*)(g + col), s1 = *(const float4*)(sc + col), s0 = *(const float4*)(sh + col);
      const float h0 = v[i].x * rstd * gg.x * (1.f + s1.x) + s0.x;
      const float h1 = v[i].y * rstd * gg.y * (1.f + s1.y) + s0.y;
      const float h2 = v[i].z * rstd * gg.z * (1.f + s1.z) + s0.z;
      const float h3 = v[i].w * rstd * gg.w * (1.f + s1.w) + s0.w;
      *(uint2*)(H + (size_t)row * 1024 + col) = make_uint2(pack2(h0, h1), pack2(h2, h3));
    }
  }
}

#define LDSAS __attribute__((address_space(3)))
DI void glds_tile(const bf16_t* gA, const bf16_t* gB, int K, int kt, bf16_t* sA, bf16_t* sB, int buf, int w, int lane) {
  const int c = (lane & 7) ^ (lane >> 3);
#pragma unroll
  for (int j = 0; j < 4; ++j) {
    const int rb = 4 * w + j, row = 8 * rb + (lane >> 3);
    const bf16_t* srcA = gA + (size_t)row * K + kt * 64 + c * 8;
    const bf16_t* srcB = gB + (size_t)row * K + kt * 64 + c * 8;
    bf16_t* dA = sA + buf * 128 * 64 + rb * 512 + lane * 8;
    bf16_t* dB = sB + buf * 128 * 64 + rb * 512 + lane * 8;
    __builtin_amdgcn_global_load_lds((const void*)srcA, (LDSAS void*)dA, 16, 0, 0);
    __builtin_amdgcn_global_load_lds((const void*)srcB, (LDSAS void*)dB, 16, 0, 0);
  }
}

template <int EPI>
DI void ph_gemm(const Params& P, int l, const bf16_t* __restrict__ A, const bf16_t* __restrict__ Bt, int M, int N, int K,
                int gidx, bool final_out, char* smem) {
  const int tid = otid(), lane = tid & 63, w = tid >> 6, wr = w >> 1, wc = w & 1, fr = lane & 15, fq = lane >> 4;
  bf16_t* sA = (bf16_t*)smem;
  bf16_t* sB = sA + 2 * 128 * 64;
  const int tm = M >> 7, tn = N >> 7, ntiles = tm * tn, nk = K >> 6;
  const int lrow = tid >> 3, lk = (tid & 7) * 8;
  const int lsw = ((tid & 7) ^ (lrow & 7)) * 8;
  auto tile_of = [&](int s_, int& m0_, int& n0_) {
    const int t = (s_ & 7) * (ntiles >> 3) + (s_ >> 3);
    const int grp = t / (8 * tn), rem = t % (8 * tn);
    m0_ = (grp * 8 + (rem & 7)) << 7; n0_ = (rem >> 3) << 7;
  };
  if ((int)blockIdx.x < ntiles) {
    int m0, n0; tile_of(blockIdx.x, m0, n0);
    glds_tile(A + (size_t)m0 * K, Bt + (size_t)n0 * K, K, 0, sA, sB, 0, w, lane);
  }
  for (int s = blockIdx.x; s < ntiles; s += gridDim.x) {
    int m0, n0; tile_of(s, m0, n0);
    const bool has_next = s + (int)gridDim.x < ntiles;
    int m0n = 0, n0n = 0;
    if (has_next) tile_of(s + gridDim.x, m0n, n0n);
    f32x4 acc[4][4];
#pragma unroll
    for (int m = 0; m < 4; ++m)
#pragma unroll
      for (int n = 0; n < 4; ++n) acc[m][n] = f32x4{0.f, 0.f, 0.f, 0.f};
    const bf16_t* gA = A + (size_t)m0 * K;
    const bf16_t* gB = Bt + (size_t)n0 * K;
    asm volatile("s_waitcnt vmcnt(0)" ::: "memory");
    __syncthreads();
    for (int kt = 0; kt < nk; ++kt) {
      const int cur = kt & 1;
      if (kt + 1 < nk) glds_tile(gA, gB, K, kt + 1, sA, sB, cur ^ 1, w, lane);
      else if (has_next) glds_tile(A + (size_t)m0n * K, Bt + (size_t)n0n * K, K, 0, sA, sB, 0, w, lane);
      const bf16_t* cA = sA + cur * 128 * 64 + (wr * 64 + fr) * 64;
      const bf16_t* cB = sB + cur * 128 * 64 + (wc * 64 + fr) * 64;
#pragma unroll
      for (int ks = 0; ks < 2; ++ks) {
        bf16x8 af[4], bfr[4];
#pragma unroll
        for (int m = 0; m < 4; ++m) af[m] = *(const bf16x8*)(cA + m * 16 * 64 + (((ks * 4 + fq) ^ (fr & 7)) * 8));
#pragma unroll
        for (int n = 0; n < 4; ++n) bfr[n] = *(const bf16x8*)(cB + n * 16 * 64 + (((ks * 4 + fq) ^ (fr & 7)) * 8));
        __builtin_amdgcn_s_setprio(1);
#pragma unroll
        for (int m = 0; m < 4; ++m)
#pragma unroll
          for (int n = 0; n < 4; ++n) acc[m][n] = MFMA16(bfr[n], af[m], acc[m][n]);
        __builtin_amdgcn_s_setprio(0);
      }
      if (kt + 1 < nk) {
        asm volatile("s_waitcnt vmcnt(0)" ::: "memory");
        __syncthreads();
      }
    }
    if (EPI == 0) {
      bf16_t* C = (bf16_t*)(P.ws + OFF_PROJ);
      const int col0 = n0 + wc * 64;
      if (col0 >= 512 && col0 < 1152) {
        const bool isq = col0 < 1024;
        const float* nw = (isq ? P.q_norm : P.k_norm) + l * 64 + fq * 4;
        const float2* ROPE = (const float2*)(P.ws + OFF_ROPE);
        float nwv[4][4];
#pragma unroll
        for (int n = 0; n < 4; ++n)
#pragma unroll
          for (int j = 0; j < 4; ++j) nwv[n][j] = nw[n * 16 + j];
#pragma unroll
        for (int m = 0; m < 4; ++m) {
          float ss = 0.f;
#pragma unroll
          for (int n = 0; n < 4; ++n)
#pragma unroll
            for (int j = 0; j < 4; ++j) ss += acc[m][n][j] * acc[m][n][j];
          ss += __shfl_xor(ss, 16);
          ss += __shfl_xor(ss, 32);
          const float rs = rsqrtf(ss * (1.f / 64.f) + 1e-6f) * (isq ? 0.125f * 1.4426950408889634f : 1.f);
#pragma unroll
          for (int n = 0; n < 4; ++n)
#pragma unroll
            for (int j = 0; j < 4; ++j) acc[m][n][j] *= rs * nwv[n][j];
          const int row = m0 + wr * 64 + m * 16 + fr;
          if (row < NLAT) {
            const int t = row & 2047;
#pragma unroll
            for (int a = 0; a < 2; ++a) {
              const int v = a == 0 ? (t >> 6) : (t & 63);
#pragma unroll
              for (int j = 0; j < 4; ++j) {
                const float2 cssn = ROPE[v * 16 + fq * 4 + j];
                const float x1 = acc[m][2 * a][j], x2 = acc[m][2 * a + 1][j];
                acc[m][2 * a][j] = x1 * cssn.x - x2 * cssn.y;
                acc[m][2 * a + 1][j] = x2 * cssn.x + x1 * cssn.y;
              }
            }
          }
        }
      }
      if (col0 >= 1152) {
        bf16_t* VT = (bf16_t*)(P.ws + OFF_VT);
#pragma unroll
        for (int m = 0; m < 4; ++m) {
          const int row = m0 + wr * 64 + m * 16 + fr;
#pragma unroll
          for (int n = 0; n < 4; ++n)
#pragma unroll
            for (int j = 0; j < 4; ++j) VT[(size_t)(col0 - 1152 + n * 16 + fq * 4 + j) * NROW + row] = f2bf(acc[m][n][j]);
        }
      } else {
#pragma unroll
        for (int m = 0; m < 4; ++m) {
          const int row = m0 + wr * 64 + m * 16 + fr;
#pragma unroll
          for (int n = 0; n < 4; ++n) {
            const int col = col0 + n * 16 + fq * 4;
            *(uint2*)(C + (size_t)row * N + col) = make_uint2(pack2(acc[m][n][0], acc[m][n][1]), pack2(acc[m][n][2], acc[m][n][3]));
          }
        }
      }
    } else if (EPI == 1) {
      float* XR = (float*)(P.ws + OFF_XRES);
      const float* MOD = (const float*)(P.ws + OFF_MOD);
      const int mr = m0 < NLAT ? (m0 >> 11) : 8;
      const float* gp = MOD + (size_t)(l * 9 + mr) * 6144 + gidx * 1024 + n0 + wc * 64 + fq * 4;
      float4 gg[4];
#pragma unroll
      for (int n = 0; n < 4; ++n) gg[n] = *(const float4*)(gp + n * 16);
      float* xbase = XR + (size_t)(m0 + wr * 64 + fr) * 1024 + n0 + wc * 64 + fq * 4;
      float4 xv[4][4];
#pragma unroll
      for (int m = 0; m < 4; ++m)
#pragma unroll
        for (int n = 0; n < 4; ++n) xv[m][n] = *(const float4*)(xbase + (size_t)m * 16 * 1024 + n * 16);
      float* obase = final_out ? P.out + (size_t)(m0 + wr * 64 + fr) * 1024 + n0 + wc * 64 + fq * 4 : xbase;
#pragma unroll
      for (int m = 0; m < 4; ++m)
#pragma unroll
        for (int n = 0; n < 4; ++n) {
          float4 o;
          o.x = xv[m][n].x + gg[n].x * acc[m][n][0]; o.y = xv[m][n].y + gg[n].y * acc[m][n][1];
          o.z = xv[m][n].z + gg[n].z * acc[m][n][2]; o.w = xv[m][n].w + gg[n].w * acc[m][n][3];
          *(float4*)(obase + (size_t)m * 16 * 1024 + n * 16) = o;
        }
    } else {
      bf16_t* ACT = (bf16_t*)(P.ws + OFF_ACT);
#pragma unroll
      for (int m = 0; m < 4; ++m) {
        const int row = m0 + wr * 64 + m * 16 + fr;
#pragma unroll
        for (int i = 0; i < 2; ++i) {
          const int col = (n0 >> 1) + wc * 32 + i * 16 + fq * 4;
          float o[4];
#pragma unroll
          for (int j = 0; j < 4; ++j) { const float gt = acc[m][2 * i][j], up = acc[m][2 * i + 1][j]; o[j] = gt * frcp(1.f + __expf(-gt)) * up; }
          *(uint2*)(ACT + (size_t)row * DFF + col) = make_uint2(pack2(o[0], o[1]), pack2(o[2], o[3]));
        }
      }
    }
  }
}

DI void attn_item(const Params& P, int l, int item, char* smem) {
  const int tid = otid(), lane = tid & 63, w = tid >> 6, r = lane & 31, h = lane >> 5;
  bf16_t* sK = (bf16_t*)smem;
  bf16_t* sV = sK + 32 * 72;
  const bf16_t* PROJ = (const bf16_t*)(P.ws + OFF_PROJ);
  bf16_t* CAT = (bf16_t*)(P.ws + OFF_CAT);
  const float2* ROPE = (const float2*)(P.ws + OFF_ROPE);
  const bool ctxq = item >= 1024;
  int b, kvh, qb;
  if (!ctxq) { b = item >> 7; kvh = (item >> 6) & 1; qb = item & 63; }
  else { const int it = item - 1024; b = it >> 4; kvh = (it >> 3) & 1; qb = it & 7; }
  const int q0 = qb * 32, head = kvh * 4 + w;
  const int qp = q0 + r;
  const int qrow = ctxq ? NLAT + b * 256 + qp : b * 2048 + qp;
  bf16x8 qf[4];
  {
    const bf16_t* qptr = PROJ + (size_t)qrow * INW + 512 + head * 64 + 8 * h;
#pragma unroll
    for (int s = 0; s < 4; ++s) qf[s] = *(const bf16x8*)(qptr + 16 * s);
  }
  int i_lo = 0, nwin = 0;
  if (!ctxq) {
    i_lo = q0 < 128 ? (128 - q0) >> 5 : 0;
    int i_hi = (2144 - q0) >> 5; if (i_hi > 8) i_hi = 8;
    nwin = i_hi - i_lo + 1;
  }
  const int nt = nwin + 8;
  const int key = tid >> 3, t8 = tid & 7;
  const int vd = tid >> 2, vc = tid & 3;
  const bf16_t* VT = (const bf16_t*)(P.ws + OFF_VT) + (size_t)(kvh * 64 + vd) * NROW + vc * 8;
  float c_off;
  {
    float wq = fabsf(P.q_norm[l * 64 + lane]), wk = fabsf(P.k_norm[l * 64 + lane]);
#pragma unroll
    for (int m = 32; m >= 1; m >>= 1) { wq = fmaxf(wq, __shfl_xor(wq, m)); wk = fmaxf(wk, __shfl_xor(wk, m)); }
    const float sink2 = P.sink[l * 8 + head] * 1.4426950408889634f;
    c_off = fminf(fmaxf(8.f * 1.4426950408889634f * 1.02f * wq * wk, sink2), 60.f);
  }
  float l_run = h == 0 ? __builtin_amdgcn_exp2f(P.sink[l * 8 + head] * 1.4426950408889634f - c_off) : 0.f;
  f32x16 oacc[2];
#pragma unroll
  for (int i = 0; i < 16; ++i) { oacc[0][i] = 0.f; oacc[1][i] = 0.f; }
  auto tile_row0 = [&](int t) -> size_t {
    const bool kc = t >= nwin;
    const int start = kc ? 32 * (t - nwin) : q0 - 128 + 32 * (i_lo + t);
    return (size_t)((kc ? NLAT + b * 256 : b * 2048) + start);
  };
  auto tile_load = [&](int t, uint4& kr, uint4& vr) {
    if (t < nt) {
      const size_t krow0 = tile_row0(t);
      kr = *(const uint4*)(PROJ + (krow0 + key) * INW + 1024 + kvh * 64 + t8 * 8);
      vr = *(const uint4*)(VT + krow0);
    }
  };
  uint4 kr0, kr1, kr2, kr3, vr0, vr1, vr2, vr3;
  kr0 = kr1 = kr2 = kr3 = vr0 = vr1 = vr2 = vr3 = make_uint4(0u, 0u, 0u, 0u);
  tile_load(0, kr0, vr0); tile_load(1, kr1, vr1); tile_load(2, kr2, vr2); tile_load(3, kr3, vr3);
  constexpr int TILE_E = 32 * 72 + 64 * 40;
  *(uint4*)(sK + key * 72 + t8 * 8) = kr0;
  *(uint4*)(sV + vd * 40 + vc * 8) = vr0;
  tile_load(4, kr0, vr0);
  __syncthreads();
  auto tile_step = [&](int t, uint4& knext, uint4& vnext) {
    const bool kc = t >= nwin;
    const int start = kc ? 32 * (t - nwin) : q0 - 128 + 32 * (i_lo + t);
    if (t + 1 < nt) {
      bf16_t* nb = sK + ((t + 1) & 1) * TILE_E;
      *(uint4*)(nb + key * 72 + t8 * 8) = knext;
      *(uint4*)(nb + 32 * 72 + vd * 40 + vc * 8) = vnext;
      tile_load(t + 5, knext, vnext);
    }
    const bf16_t* sKc = sK + (t & 1) * TILE_E;
    const bf16_t* sVc = sKc + 32 * 72;
    f32x16 sacc;
#pragma unroll
    for (int i = 0; i < 16; ++i) sacc[i] = 0.f;
#pragma unroll
    for (int s = 0; s < 4; ++s) {
      const bf16x8 kf = *(const bf16x8*)(sKc + r * 72 + 16 * s + 8 * h);
      sacc = MFMA32(kf, qf[s], sacc);
    }
    if (!kc && (start < q0 - 97 || start > q0 + 97)) {
#pragma unroll
      for (int i = 0; i < 16; ++i) {
        const int d = start + crow32(i, h) - qp;
        if (d > 128 || d < -128) sacc[i] = -INFINITY;
      }
    }
    float psum = 0.f;
#pragma unroll
    for (int i = 0; i < 16; ++i) { sacc[i] = __builtin_amdgcn_exp2f(sacc[i] - c_off); psum += sacc[i]; }
    l_run += psum;
    bf16x8 pf[2];
#pragma unroll
    for (int s2 = 0; s2 < 2; ++s2)
      pf[s2] = __builtin_bit_cast(bf16x8, make_uint4(pack2(sacc[8 * s2 + 0], sacc[8 * s2 + 1]), pack2(sacc[8 * s2 + 2], sacc[8 * s2 + 3]),
                                                      pack2(sacc[8 * s2 + 4], sacc[8 * s2 + 5]), pack2(sacc[8 * s2 + 6], sacc[8 * s2 + 7])));
#pragma unroll
    for (int db = 0; db < 2; ++db)
#pragma unroll
      for (int s2 = 0; s2 < 2; ++s2) {
        const bf16_t* vrow = sVc + (32 * db + r) * 40 + 16 * s2 + 4 * h;
        const uint2 lo = *(const uint2*)(vrow), hi = *(const uint2*)(vrow + 8);
        const bf16x8 vf = __builtin_bit_cast(bf16x8, make_uint4(lo.x, lo.y, hi.x, hi.y));
        oacc[db] = MFMA32(vf, pf[s2], oacc[db]);
      }
    __syncthreads();
  };
  for (int t0 = 0; t0 < nt; t0 += 4) {
    tile_step(t0, kr1, vr1);
    if (t0 + 1 < nt) tile_step(t0 + 1, kr2, vr2);
    if (t0 + 2 < nt) tile_step(t0 + 2, kr3, vr3);
    if (t0 + 3 < nt) tile_step(t0 + 3, kr0, vr0);
  }
  const float ltot = l_run + __shfl_xor(l_run, 32);
  const float inv = frcp(ltot);
  bf16_t* op = CAT + (size_t)qrow * 1024 + 512 + head * 64;
#pragma unroll
  for (int db = 0; db < 2; ++db)
#pragma unroll
    for (int g4 = 0; g4 < 4; ++g4) {
      const int d = 32 * db + 8 * g4 + 4 * h;
      *(uint2*)(op + d) = make_uint2(pack2(oacc[db][4 * g4 + 0] * inv, oacc[db][4 * g4 + 1] * inv), pack2(oacc[db][4 * g4 + 2] * inv, oacc[db][4 * g4 + 3] * inv));
    }
}

template <int HALF>
DI void pool_diffs(const float (&u)[48], bf16_t* sd, int tid, int t0, int Lseq) {
  float s = 0.f;
#pragma unroll
  for (int i = 8 - HALF; i < 8 + HALF; ++i) s += u[i];
#pragma unroll
  for (int tt = 0; tt < 32; ++tt) {
    if (tt > 0) s += u[8 + tt + HALF - 1] - u[8 + tt - HALF - 1];
    const int t = t0 + tt;
    const int cnt = min(t + HALF, Lseq) - max(t - HALF, 0);
    sd[tt * 264 + tid] = f2bf(s * frcp((float)cnt) - u[8 + tt]);
  }
}

DI void pool_item(const Params& P, int l, int item, char* smem) {
  const int tid = otid();
  bf16_t* sd = (bf16_t*)smem;
  const bf16_t* PROJ = (const bf16_t*)(P.ws + OFF_PROJ);
  bf16_t* CAT = (bf16_t*)(P.ws + OFF_CAT);
  const int row0 = item * 32;
  const int seqstart = row0 < NLAT ? (row0 & ~2047) : NLAT + ((row0 - NLAT) & ~255);
  const int Lseq = row0 < NLAT ? 2048 : 256;
  const int t0 = row0 - seqstart;
  const int gi = __builtin_amdgcn_readfirstlane(tid >> 6);
  {
    float u[48];
#pragma unroll
    for (int i = 0; i < 48; ++i) {
      const int t = t0 - 8 + i;
      const int tc = min(max(t, 0), Lseq - 1);
      const float v = bf2f(PROJ[(size_t)(seqstart + tc) * INW + tid]);
      u[i] = (t >= 0 && t < Lseq) ? v : 0.f;
    }
    if (gi == 0) pool_diffs<1>(u, sd, tid, t0, Lseq);
    else if (gi == 1) pool_diffs<2>(u, sd, tid, t0, Lseq);
    else if (gi == 2) pool_diffs<4>(u, sd, tid, t0, Lseq);
    else pool_diffs<8>(u, sd, tid, t0, Lseq);
  }
  const int lane = tid & 63, fr = lane & 15, fq = lane >> 4;
  const bf16_t* wt = (const bf16_t*)(P.ws + OFF_POOLT) + (size_t)(l * 4 + gi) * 4096 + (size_t)fr * 64 + fq * 8;
  bf16x8 bfr[2][4];
#pragma unroll
  for (int ks = 0; ks < 2; ++ks)
#pragma unroll
    for (int n = 0; n < 4; ++n) bfr[ks][n] = *(const bf16x8*)(wt + n * 16 * 64 + ks * 32);
  float4 sc4[4];
#pragma unroll
  for (int n = 0; n < 4; ++n) sc4[n] = *(const float4*)(P.pool_scale + l * 256 + gi * 64 + n * 16 + fq * 4);
  __syncthreads();
  f32x4 acc[2][4];
#pragma unroll
  for (int m = 0; m < 2; ++m)
#pragma unroll
    for (int n = 0; n < 4; ++n) acc[m][n] = f32x4{0.f, 0.f, 0.f, 0.f};
#pragma unroll
  for (int ks = 0; ks < 2; ++ks) {
    bf16x8 af[2];
#pragma unroll
    for (int m = 0; m < 2; ++m) af[m] = *(const bf16x8*)(sd + (m * 16 + fr) * 264 + gi * 64 + ks * 32 + fq * 8);
#pragma unroll
    for (int m = 0; m < 2; ++m)
#pragma unroll
      for (int n = 0; n < 4; ++n) acc[m][n] = MFMA16(bfr[ks][n], af[m], acc[m][n]);
  }
#pragma unroll
  for (int m = 0; m < 2; ++m)
#pragma unroll
    for (int n = 0; n < 4; ++n)
      *(uint2*)(CAT + (size_t)(row0 + m * 16 + fr) * 1024 + gi * 64 + n * 16 + fq * 4) =
          make_uint2(pack2(acc[m][n][0] * sc4[n].x, acc[m][n][1] * sc4[n].y), pack2(acc[m][n][2] * sc4[n].z, acc[m][n][3] * sc4[n].w));
}

DI int chunk_rowbase(int b, int kap) { return kap < 4 ? NLAT + b * 256 + kap * 64 : b * 2048 + (kap - 4) * 64; }

DI void ssm1_item(const Params& P, int l, int item) {
  const int tid = otid(), lane = tid & 63, w = tid >> 6, n = lane & 15, q = lane >> 4;
  const int g = item / 36, dir = (item / 18) & 1, cb = item % 18;
  const int tb = (l * 16 + g) * 2 + dir;
  const int col = cb * 16 + n, b = col / 36, kap = col % 36;
  const bf16_t* up = (const bf16_t*)(P.ws + OFF_PROJ) + (size_t)chunk_rowbase(b, kap) * INW + 256 + g * 16 + 8 * (q & 1) + (size_t)(q >> 1) * INW;
  const bf16_t* ep = (const bf16_t*)(P.ws + OFF_ETAB) + (size_t)tb * 131072 + (size_t)((2 * w) * 16 + n) * 1024 + 8 * q;
  f32x4 acc0 = {0.f, 0.f, 0.f, 0.f}, acc1 = {0.f, 0.f, 0.f, 0.f};
#pragma unroll 8
  for (int ks = 0; ks < 32; ++ks) {
    const bf16x8 bq = *(const bf16x8*)(up + (size_t)(2 * ks) * INW);
    const bf16x8 a0 = *(const bf16x8*)(ep + ks * 32);
    const bf16x8 a1 = *(const bf16x8*)(ep + 16 * 1024 + ks * 32);
    acc0 = MFMA16(a0, bq, acc0);
    acc1 = MFMA16(a1, bq, acc1);
  }
  float* SL = (float*)(P.ws + OFF_SLOC) + ((size_t)((b * 16 + g) * 2 + dir) * 36 + kap) * 128;
  *(float4*)(SL + (2 * w) * 16 + 4 * q) = make_float4(acc0[0], acc0[1], acc0[2], acc0[3]);
  *(float4*)(SL + (2 * w + 1) * 16 + 4 * q) = make_float4(acc1[0], acc1[1], acc1[2], acc1[3]);
}

DI void ssm3_item(const Params& P, int l, int item, char* smem) {
  const int tid = otid(), lane = tid & 63, w = tid >> 6, n = lane & 15, q = lane >> 4;
  const int g = item / 36, dir = (item / 18) & 1, cb = item % 18;
  const int tb = (l * 16 + g) * 2 + dir;
  bf16_t* sst = (bf16_t*)smem;
  bf16_t* sK = sst + 16 * 128;
  char* sU = (char*)(sK + 64 * 256);
  const bf16_t* PROJ = (const bf16_t*)(P.ws + OFF_PROJ);
  struct U8 { uint4 v0, v1, v2, v3, v4, v5, v6, v7; };
  U8 ureg;
  const int bsel = tid >> 6, sp = tid & 63;
  const int bs_raw = (cb * 16) / 36 + bsel;
  const bool scan_on = tid < 128 && bs_raw <= (cb * 16 + 15) / 36;
  const int bs = scan_on ? bs_raw : (cb * 16) / 36;
  float lr[36], li[36];
  {
    const uint4* src = (const uint4*)((const bf16_t*)(P.ws + OFF_KTAB) + (size_t)tb * 16384) + tid;
    uint4 k0 = src[0], k1 = src[256], k2 = src[512], k3 = src[768], k4 = src[1024], k5 = src[1280], k6 = src[1536], k7 = src[1792];
    const float* SL = (const float*)(P.ws + OFF_SLOC) + (size_t)((bs * 16 + g) * 2 + dir) * 36 * 128 + sp;
#pragma unroll
    for (int step = 0; step < 36; ++step) {
      const int kap = dir == 0 ? step : (step < 4 ? 3 - step : 39 - step);
      lr[step] = SL[kap * 128]; li[step] = SL[kap * 128 + 64];
    }
    auto uload = [&](int i, int hf) {
      const int idx = tid + 256 * i, row = idx >> 1, half = idx & 1, nn = row >> 5, off = (row & 31) + 32 * hf;
      const int colg = cb * 16 + nn;
      return *(const uint4*)(PROJ + (size_t)(chunk_rowbase(colg / 36, colg % 36) + off) * INW + 256 + g * 16 + half * 8);
    };
    ureg.v0 = uload(0, 0); ureg.v1 = uload(1, 0); ureg.v2 = uload(2, 0); ureg.v3 = uload(3, 0);
    ureg.v4 = uload(0, 1); ureg.v5 = uload(1, 1); ureg.v6 = uload(2, 1); ureg.v7 = uload(3, 1);
    uint4* d = (uint4*)sK + tid;
    d[0] = k0; d[256] = k1; d[512] = k2; d[768] = k3; d[1024] = k4; d[1280] = k5; d[1536] = k6; d[1792] = k7;
  }
  if (scan_on) {
    const float2 aT = ((const float2*)(P.ws + OFF_AT))[tb * 64 + sp];
    float sr = 0.f, si = 0.f;
#pragma unroll
    for (int step = 0; step < 36; ++step) {
      const int kap = dir == 0 ? step : (step < 4 ? 3 - step : 39 - step);
      const int nloc = bs * 36 + kap - cb * 16;
      if (nloc >= 0 && nloc < 16) { sst[nloc * 128 + sp] = f2bf(sr); sst[nloc * 128 + 64 + sp] = f2bf(si); }
      const float nr = aT.x * sr - aT.y * si + lr[step], ni = aT.x * si + aT.y * sr + li[step];
      sr = nr; si = ni;
    }
  }
  const bf16_t* FT = (const bf16_t*)(P.ws + OFF_FTAB) + (size_t)tb * 131072 + (size_t)n * 128 + 8 * q;
  float* Y = (float*)(P.ws + OFF_YSSM) + (size_t)(dir * 16 + g) * NROW * 16;
  const bf16x8 zero8 = {0, 0, 0, 0, 0, 0, 0, 0};
  {
    const int colg = cb * 16 + n;
    const bool valid = true;
    const int kapc = n;
    const int rowbase = chunk_rowbase(colg / 36, colg % 36);
    f32x4 acc[16];
#pragma unroll
    for (int oi = 0; oi < 16; ++oi) acc[oi] = f32x4{0.f, 0.f, 0.f, 0.f};
    const char* ub = sU + n * 1056 + (q >> 1) * 32 + (q & 1) * 16;
    const char* kb = (const char*)sK + n * 32 + (q & 1) * 16;
    const int wu = __builtin_amdgcn_readfirstlane(w);
    auto half_body = [&](const int hf, const uint4 u0, const uint4 u1, const uint4 u2, const uint4 u3) {
      __syncthreads();
      {
        const int r0 = tid >> 1, h0 = tid & 1;
        char* d = sU + (r0 >> 5) * 1056 + (r0 & 31) * 32 + h0 * 16;
        *(uint4*)(d) = u0; *(uint4*)(d + 4 * 1056) = u1; *(uint4*)(d + 8 * 1056) = u2; *(uint4*)(d + 12 * 1056) = u3;
      }
      __syncthreads();
#pragma unroll
      for (int G = 0; G < 4; ++G) {
        int ks_lo = dir == 0 ? 0 : ((wu + 16 * G) >> 1);
        int ks_hi = dir == 0 ? ((wu + 16 * G + 12) >> 1) : 31;
        ks_lo = max(ks_lo, 16 * hf);
        ks_hi = min(ks_hi, 16 * hf + 15);
#pragma unroll 2
        for (int ks = ks_lo; ks <= ks_hi; ++ks) {
          const bf16x8 bq = *(const bf16x8*)(ub + (ks - 16 * hf) * 64);
          const int off_in = 2 * ks + (q >> 1);
#pragma unroll
          for (int i = 0; i < 4; ++i) {
            const int off_out = w + 16 * G + 4 * i;
            const int tau = dir == 0 ? off_out - off_in : off_in - off_out;
            const int tc = tau < 0 ? 0 : tau;
            bf16x8 a = *(const bf16x8*)(kb + tc * 512);
            if (tau < 0) a = zero8;
            acc[4 * G + i] = MFMA16(a, bq, acc[4 * G + i]);
          }
        }
      }
    };
    half_body(0, ureg.v0, ureg.v1, ureg.v2, ureg.v3);
    half_body(1, ureg.v4, ureg.v5, ureg.v6, ureg.v7);
    bf16x8 sb[4];
#pragma unroll
    for (int k2 = 0; k2 < 4; ++k2) sb[k2] = *(const bf16x8*)(sst + kapc * 128 + k2 * 32 + 8 * q);
#pragma unroll
    for (int oh = 0; oh < 2; ++oh) {
      bf16x8 fa[8][4];
#pragma unroll
      for (int o2 = 0; o2 < 8; ++o2)
#pragma unroll
        for (int k2 = 0; k2 < 4; ++k2) fa[o2][k2] = *(const bf16x8*)(FT + (size_t)(w + 4 * (8 * oh + o2)) * 16 * 128 + k2 * 32);
#pragma unroll
      for (int o2 = 0; o2 < 8; ++o2)
#pragma unroll
        for (int k2 = 0; k2 < 4; ++k2) acc[8 * oh + o2] = MFMA16(fa[o2][k2], sb[k2], acc[8 * oh + o2]);
    }
    if (valid) {
#pragma unroll
      for (int oi = 0; oi < 16; ++oi)
        *(float4*)(Y + (size_t)(rowbase + w + 4 * oi) * 16 + 4 * q) = make_float4(acc[oi][0], acc[oi][1], acc[oi][2], acc[oi][3]);
    }
  }
}

DI void glu_item(const Params& P, int l, int item, char* smem) {
  const int tid = otid(), lane = tid & 63, w = tid >> 6, fr = lane & 15, fq = lane >> 4;
  bf16_t* sG = (bf16_t*)smem;
  const int row0 = item * 64;
  const bf16_t* PROJ = (const bf16_t*)(P.ws + OFF_PROJ);
  const float* Y0 = (const float*)(P.ws + OFF_YSSM);
  const float* Y1 = Y0 + (size_t)NROW * 256;
  bf16_t* CAT = (bf16_t*)(P.ws + OFF_CAT);
#pragma unroll 4
  for (int i = 0; i < 16; ++i) {
    const int rr = tid >> 2, c4 = i * 16 + (tid & 3) * 4;
    const size_t row = (size_t)(row0 + rr);
    const float4 a = *(const float4*)(Y0 + ((size_t)i * NROW + row) * 16 + (tid & 3) * 4), bb = *(const float4*)(Y1 + ((size_t)i * NROW + row) * 16 + (tid & 3) * 4);
    const float4 dd = *(const float4*)(P.ssm_d + l * 256 + c4);
    const uint2 ur = *(const uint2*)(PROJ + row * INW + 256 + c4);
    float y[4] = {dd.x * bflo(ur.x) + a.x + bb.x, dd.y * bfhi(ur.x) + a.y + bb.y, dd.z * bflo(ur.y) + a.z + bb.z, dd.w * bfhi(ur.y) + a.w + bb.w};
#pragma unroll
    for (int j = 0; j < 4; ++j) {
      const float v = y[j];
      const float u = 0.7978845608028654f * (v + 0.044715f * v * v * v);
      const float th = 1.f - 2.f * frcp(1.f + __expf(2.f * u));
      y[j] = 0.5f * v * (1.f + th);
    }
    *(uint2*)(sG + rr * 264 + c4) = make_uint2(pack2(y[0], y[1]), pack2(y[2], y[3]));
  }
  __syncthreads();
  f32x4 acc[4][4];
#pragma unroll
  for (int m = 0; m < 4; ++m)
#pragma unroll
    for (int nn = 0; nn < 4; ++nn) acc[m][nn] = f32x4{0.f, 0.f, 0.f, 0.f};
  const bf16_t* GT = (const bf16_t*)(P.ws + OFF_GLUT) + (size_t)l * 65536 + (size_t)(w * 64 + fr) * 256 + fq * 8;
#pragma unroll 4
  for (int ks = 0; ks < 8; ++ks) {
    bf16x8 af[4], bfr[4];
#pragma unroll
    for (int m = 0; m < 4; ++m) af[m] = *(const bf16x8*)(sG + (m * 16 + fr) * 264 + ks * 32 + fq * 8);
#pragma unroll
    for (int nn = 0; nn < 4; ++nn) bfr[nn] = *(const bf16x8*)(GT + (size_t)nn * 16 * 256 + ks * 32);
#pragma unroll
    for (int m = 0; m < 4; ++m)
#pragma unroll
      for (int nn = 0; nn < 4; ++nn) acc[m][nn] = MFMA16(bfr[nn], af[m], acc[m][nn]);
  }
#pragma unroll
  for (int m = 0; m < 4; ++m) {
    const int rr = m * 16 + fr;
#pragma unroll
    for (int nn = 0; nn < 4; ++nn) {
      const int col = w * 64 + nn * 16 + fq * 4;
      const float4 gb = *(const float4*)(P.glu_b + l * 256 + col);
      const uint2 gr = *(const uint2*)(sG + rr * 264 + col);
      const float z0 = acc[m][nn][0] + gb.x, z1 = acc[m][nn][1] + gb.y, z2 = acc[m][nn][2] + gb.z, z3 = acc[m][nn][3] + gb.w;
      const float o0 = bflo(gr.x) * frcp(1.f + __expf(-z0)), o1 = bfhi(gr.x) * frcp(1.f + __expf(-z1));
      const float o2 = bflo(gr.y) * frcp(1.f + __expf(-z2)), o3 = bfhi(gr.y) * frcp(1.f + __expf(-z3));
      *(uint2*)(CAT + (size_t)(row0 + rr) * 1024 + 256 + col) = make_uint2(pack2(o0, o1), pack2(o2, o3));
    }
  }
}

#define XB_TMO      128
#define XB_XCNT(j)  (256  + 64 * (j))
#define XB_XSUB(j)  (1280 + 64 * (j))
#define XB_XGEN(j)  (2304 + 64 * (j))
#define XB_TOP      3328
#define XB_TOPGEN   3392
#define XCD_BAR_WORDS 3456
#define XB_SPIN_CAP (1u << 21)
#define LAS __attribute__((address_space(3)))

__device__ __forceinline__ unsigned xb_ld(unsigned* p)              { return __hip_atomic_load(p, __ATOMIC_RELAXED, __HIP_MEMORY_SCOPE_AGENT); }
__device__ __forceinline__ unsigned xb_add(unsigned* p, unsigned v) { return __hip_atomic_fetch_add(p, v, __ATOMIC_RELAXED, __HIP_MEMORY_SCOPE_AGENT); }
__device__ __forceinline__ unsigned xb_xcc_id() { return (unsigned)__builtin_amdgcn_s_getreg((3 << 11) | 20) & 0xFu; }
#define XB_SPIN(cond, bar) do { unsigned _sp = 0; while (cond) { __builtin_amdgcn_s_sleep(1); \
    if ((++_sp & 255u) == 0u) { if (xb_ld(&(bar)[XB_TMO])) break; if (_sp > XB_SPIN_CAP) { atomicAdd(&(bar)[XB_TMO], 1u); break; } } } } while (0)

struct XcdBarrier {
    unsigned* bar; unsigned x;
    volatile LAS unsigned* st;
};

__device__ __forceinline__ XcdBarrier xcd_barrier_post(unsigned* bar, volatile LAS unsigned* st) {
    XcdBarrier b; b.bar = bar; b.x = xb_xcc_id(); b.st = st;
    if (threadIdx.x == 0) (void)xb_add(&bar[XB_XCNT(b.x)], 1u);
    return b;
}
__device__ __forceinline__ void xcd_barrier_complete(unsigned* bar, unsigned x, unsigned& nloc, unsigned& nx) {
    const unsigned G = gridDim.x * gridDim.y * gridDim.z;
    unsigned sum, cnt, mine, sp = 0u;
    for (;;) {
        sum = 0u; cnt = 0u; mine = 0u;
#pragma unroll
        for (unsigned j = 0; j < 16; ++j) { const unsigned c = xb_ld(&bar[XB_XCNT(j)]); sum += c; cnt += (c > 0u) ? 1u : 0u; mine = (j == x) ? c : mine; }
        if (sum == G) break;
        __builtin_amdgcn_s_sleep(1);
        if ((++sp & 255u) == 0u) { if (xb_ld(&bar[XB_TMO])) break; if (sp > XB_SPIN_CAP) { atomicAdd(&bar[XB_TMO], 1u); break; } }
    }
    nloc = mine > 0u ? mine : 1u; nx = cnt > 0u ? cnt : 1u;
}

__device__ __forceinline__ void xcd_barrier(const XcdBarrier& b) {
    asm volatile("s_waitcnt vmcnt(0)" ::: "memory");
    __syncthreads();
    if (threadIdx.x == 0) {
        unsigned* bar = b.bar;
        __builtin_amdgcn_s_waitcnt(0);
        unsigned nloc = b.st[0], nx = b.st[1];
        if (nloc == 0u) { xcd_barrier_complete(bar, b.x, nloc, nx); b.st[0] = nloc; b.st[1] = nx; }
        const unsigned old = xb_add(&bar[XB_XSUB(b.x)], 1u);
        const unsigned gen = old / nloc;
        if (old + 1u == (gen + 1u) * nloc) {
            __builtin_amdgcn_fence(__ATOMIC_RELEASE, "agent");
            asm volatile("s_waitcnt vmcnt(0)" ::: "memory");
            const unsigned og = xb_add(&bar[XB_TOP], 1u);
            const unsigned tg = og / nx;
            if (og + 1u == (tg + 1u) * nx) xb_add(&bar[XB_TOPGEN], 1u);
            else XB_SPIN(xb_ld(&bar[XB_TOPGEN]) == tg, bar);
            __builtin_amdgcn_fence(__ATOMIC_ACQUIRE, "agent");
            xb_add(&bar[XB_XGEN(b.x)], 1u);
            asm volatile("s_waitcnt vmcnt(0)" ::: "memory");
        } else {
            XB_SPIN(xb_ld(&bar[XB_XGEN(b.x)]) == gen, bar);
            __builtin_amdgcn_fence(__ATOMIC_ACQUIRE, "agent");
            asm volatile("s_waitcnt vmcnt(0)" ::: "memory");
        }
    }
    __syncthreads();
}


constexpr int NPHASES = 1 + 4 * 9;

template <int SP>
DI void run_sub(const Params& P, int l, char* smem) {
  const bool last = l == 3;
  const int rows_act = last ? NLAT : NROW;
  if constexpr (SP == 9) { ph_prologue(P, smem); }
  else if constexpr (SP == 0) { ph_norm(P, l, 0, NROW); }
  else if constexpr (SP == 1) { ph_gemm<0>(P, l, (const bf16_t*)(P.ws + OFF_H), (const bf16_t*)(P.ws + OFF_WIN) + l * W_IN_E, NROW, INW, DM, 0, false, smem); }
  else if constexpr (SP == 2) {
    const int nattn = last ? 1024 : 1152;
    const int total = nattn + 576;
    for (int it = blockIdx.x; it < total; it += gridDim.x) {
      if (it < nattn) attn_item(P, l, it, smem);
      else ssm1_item(P, l, it - nattn);
      __syncthreads();
    }
  }
  else if constexpr (SP == 3) {
    const int npool = rows_act / 32;
    for (int it = blockIdx.x; it < 576 + npool; it += gridDim.x) {
      if (it < 576) ssm3_item(P, l, it, smem);
      else pool_item(P, l, it - 576, smem);
      __syncthreads();
    }
  }
  else if constexpr (SP == 4) { for (int it = blockIdx.x; it < rows_act / 64; it += gridDim.x) { glu_item(P, l, it, smem); __syncthreads(); } }
  else if constexpr (SP == 5) { ph_gemm<1>(P, l, (const bf16_t*)(P.ws + OFF_CAT), (const bf16_t*)(P.ws + OFF_WOUT) + l * W_OUT_E, rows_act, DM, DM, 2, false, smem); }
  else if constexpr (SP == 6) { ph_norm(P, l, 1, rows_act); }
  else if constexpr (SP == 7) { ph_gemm<2>(P, l, (const bf16_t*)(P.ws + OFF_H), (const bf16_t*)(P.ws + OFF_WGU) + l * W_GU_E, rows_act, 2 * DFF, DM, 0, false, smem); }
  else if constexpr (SP == 8) { ph_gemm<1>(P, l, (const bf16_t*)(P.ws + OFF_ACT), (const bf16_t*)(P.ws + OFF_WD) + l * W_D_E, rows_act, DM, DFF, 5, last, smem); }
}

DI void run_phase(const Params& P, int ph, char* smem) {
  if (ph == 0) { run_sub<9>(P, 0, smem); return; }
  const int l = (ph - 1) / 9, sp = (ph - 1) % 9;
  switch (sp) {
    case 0: run_sub<0>(P, l, smem); break;
    case 1: run_sub<1>(P, l, smem); break;
    case 2: run_sub<2>(P, l, smem); break;
    case 3: run_sub<3>(P, l, smem); break;
    case 4: run_sub<4>(P, l, smem); break;
    case 5: run_sub<5>(P, l, smem); break;
    case 6: run_sub<6>(P, l, smem); break;
    case 7: run_sub<7>(P, l, smem); break;
    case 8: run_sub<8>(P, l, smem); break;
  }
}

extern __shared__ __attribute__((aligned(16))) char dyn_smem[];

#if !MEGA
template <int SP> __global__ void __launch_bounds__(NTHREADS, 2) k_sub(Params P, int l) { run_sub<SP>(P, l, dyn_smem); }
#endif

#if MEGA
__global__ void __launch_bounds__(NTHREADS, 2) k_mega(Params P) {
  cg::grid_group grid = cg::this_grid();
  uint4* xbw = (uint4*)(dyn_smem + LDS_PHASE);
  if (threadIdx.x == 0) *xbw = make_uint4(0u, 0u, 0u, 0u);
  __syncthreads();
  XcdBarrier xb = xcd_barrier_post((unsigned*)(P.ws + OFF_BAR), (volatile LAS unsigned*)xbw);
  run_sub<9>(P, 0, dyn_smem);
  if (P.ws == nullptr) grid.sync();
  xcd_barrier(xb);
#pragma unroll 1
  for (int l = 0; l < 4; ++l) {
    run_sub<0>(P, l, dyn_smem); xcd_barrier(xb);
    run_sub<1>(P, l, dyn_smem); xcd_barrier(xb);
    run_sub<2>(P, l, dyn_smem); xcd_barrier(xb);
    run_sub<3>(P, l, dyn_smem); xcd_barrier(xb);
    run_sub<4>(P, l, dyn_smem); xcd_barrier(xb);
    run_sub<5>(P, l, dyn_smem); xcd_barrier(xb);
    run_sub<6>(P, l, dyn_smem); xcd_barrier(xb);
    run_sub<7>(P, l, dyn_smem); xcd_barrier(xb);
    run_sub<8>(P, l, dyn_smem);
    if (l < 3) xcd_barrier(xb);
  }
}
#define OCC_KERNEL k_mega
#else
#define OCC_KERNEL k_sub<1>
#endif

extern "C" void kernel_launch(void* const* d_in, const int* in_sizes, int n_in, void* d_out, int out_size, void* d_ws, size_t ws_size,
                              hipStream_t stream) {
  if (n_in < 28 || ws_size < WS_END) { fprintf(stderr, "kernel_launch: bad inputs (n_in %d, ws %zu < %zu)\n", n_in, ws_size, (size_t)WS_END); return; }
  Params P{};
  const float** pp = (const float**)&P;
  for (int i = 0; i < 28; ++i) pp[i] = (const float*)d_in[i];
  P.out = (float*)d_out;
  P.ws = (char*)d_ws;
  static int grid_blocks = 0;
  if (!grid_blocks) {
    int dev = 0, cus = 0, per_cu = 0;
    hipGetDevice(&dev);
    hipDeviceGetAttribute(&cus, hipDeviceAttributeMultiprocessorCount, dev);
#if MEGA
    hipFuncSetAttribute((const void*)k_mega, hipFuncAttributeMaxDynamicSharedMemorySize, LDS_BYTES);
#endif
#if !MEGA
    hipFuncSetAttribute((const void*)k_sub<0>, hipFuncAttributeMaxDynamicSharedMemorySize, LDS_BYTES);
    hipFuncSetAttribute((const void*)k_sub<1>, hipFuncAttributeMaxDynamicSharedMemorySize, LDS_BYTES);
    hipFuncSetAttribute((const void*)k_sub<2>, hipFuncAttributeMaxDynamicSharedMemorySize, LDS_BYTES);
    hipFuncSetAttribute((const void*)k_sub<3>, hipFuncAttributeMaxDynamicSharedMemorySize, LDS_BYTES);
    hipFuncSetAttribute((const void*)k_sub<4>, hipFuncAttributeMaxDynamicSharedMemorySize, LDS_BYTES);
    hipFuncSetAttribute((const void*)k_sub<5>, hipFuncAttributeMaxDynamicSharedMemorySize, LDS_BYTES);
    hipFuncSetAttribute((const void*)k_sub<6>, hipFuncAttributeMaxDynamicSharedMemorySize, LDS_BYTES);
    hipFuncSetAttribute((const void*)k_sub<7>, hipFuncAttributeMaxDynamicSharedMemorySize, LDS_BYTES);
    hipFuncSetAttribute((const void*)k_sub<8>, hipFuncAttributeMaxDynamicSharedMemorySize, LDS_BYTES);
    hipFuncSetAttribute((const void*)k_sub<9>, hipFuncAttributeMaxDynamicSharedMemorySize, LDS_BYTES);
#endif
    hipOccupancyMaxActiveBlocksPerMultiprocessor(&per_cu, (const void*)OCC_KERNEL, NTHREADS, LDS_BYTES);
    if (per_cu < 1) per_cu = 1;
    if (per_cu > 2) per_cu = 2;
    grid_blocks = cus * per_cu;
  }
#if MEGA
  hipMemsetAsync((char*)d_ws + OFF_BAR, 0, BAR_BYTES, stream);
  void* args[] = {&P};
  hipError_t e = hipLaunchCooperativeKernel((const void*)k_mega, dim3(grid_blocks), dim3(NTHREADS), args, LDS_BYTES, stream);
  if (e != hipSuccess) fprintf(stderr, "cooperative launch failed: %s (grid %d)\n", hipGetErrorString(e), grid_blocks);
#else
  const dim3 G(grid_blocks), T(NTHREADS);
  k_sub<9><<<G, T, LDS_BYTES, stream>>>(P, 0);
  for (int l = 0; l < 4; ++l) {
    k_sub<0><<<G, T, LDS_BYTES, stream>>>(P, l);
    k_sub<1><<<G, T, LDS_BYTES, stream>>>(P, l);
    k_sub<2><<<G, T, LDS_BYTES, stream>>>(P, l);
    k_sub<3><<<G, T, LDS_BYTES, stream>>>(P, l);
    k_sub<4><<<G, T, LDS_BYTES, stream>>>(P, l);
    k_sub<5><<<G, T, LDS_BYTES, stream>>>(P, l);
    k_sub<6><<<G, T, LDS_BYTES, stream>>>(P, l);
    k_sub<7><<<G, T, LDS_BYTES, stream>>>(P, l);
    k_sub<8><<<G, T, LDS_BYTES, stream>>>(P, l);
  }
#endif
}
```

```cpp
#include <hip/hip_runtime.h>
#include <hip/hip_cooperative_groups.h>
#include <stdint.h>
#include <stdio.h>
namespace cg = cooperative_groups;

#ifndef MEGA
#define MEGA 1
#endif

typedef unsigned short bf16_t;
using bf16x8 = __attribute__((ext_vector_type(8))) short;
using f32x4 = __attribute__((ext_vector_type(4))) float;
using f32x16 = __attribute__((ext_vector_type(16))) float;
#define DI __device__ __forceinline__
#define MFMA16(a, b, c) __builtin_amdgcn_mfma_f32_16x16x32_bf16((a), (b), (c), 0, 0, 0)
#define MFMA32(a, b, c) __builtin_amdgcn_mfma_f32_32x32x16_bf16((a), (b), (c), 0, 0, 0)

constexpr int NLAT = 16384, NROW = 18432, DM = 1024, INW = 1280, DFF = 2816;
constexpr int LDS_PHASE = 65536;
constexpr int LDS_BYTES = LDS_PHASE + 16;
constexpr int NTHREADS = 256;

constexpr size_t OFF_XRES = 0;
constexpr size_t OFF_H = OFF_XRES + (size_t)NROW * DM * 4;
constexpr size_t OFF_UNI = OFF_H + (size_t)NROW * DM * 2;
constexpr size_t OFF_PROJ = OFF_UNI;
constexpr size_t OFF_CAT = OFF_PROJ + (size_t)NROW * INW * 2;
constexpr size_t OFF_YSSM = OFF_CAT + (size_t)NROW * DM * 2;
constexpr size_t OFF_VT = OFF_YSSM;
constexpr size_t OFF_ACT = OFF_UNI;
constexpr size_t OFF_W = OFF_YSSM + (size_t)2 * NROW * 256 * 4;
constexpr size_t W_IN_E = (size_t)INW * DM, W_OUT_E = (size_t)DM * DM, W_GU_E = (size_t)2 * DFF * DM, W_D_E = (size_t)DM * DFF, W_GLU_E = 65536;
constexpr size_t OFF_WIN = OFF_W;
constexpr size_t OFF_WOUT = OFF_WIN + 4 * W_IN_E * 2;
constexpr size_t OFF_WGU = OFF_WOUT + 4 * W_OUT_E * 2;
constexpr size_t OFF_WD = OFF_WGU + 4 * W_GU_E * 2;
constexpr size_t OFF_GLUT = OFF_WD + 4 * W_D_E * 2;
constexpr size_t OFF_MOD = OFF_GLUT + 4 * W_GLU_E * 2;
constexpr size_t OFF_KTAB = OFF_MOD + (size_t)4 * 9 * 6144 * 4;
constexpr size_t OFF_ETAB = OFF_KTAB + (size_t)128 * 16384 * 2;
constexpr size_t OFF_FTAB = OFF_ETAB + (size_t)128 * 131072 * 2;
constexpr size_t OFF_AT = OFF_FTAB + (size_t)128 * 131072 * 2;
constexpr size_t OFF_ROPE = OFF_AT + (size_t)128 * 64 * 8;
constexpr size_t OFF_BAR = OFF_ROPE + 64 * 16 * 8;
constexpr size_t BAR_BYTES = 3456 * 4;
constexpr size_t OFF_POOLT = OFF_BAR + BAR_BYTES;
constexpr size_t WS_END = OFF_POOLT + (size_t)4 * 4 * 64 * 64 * 2;
constexpr size_t OFF_SLOC = OFF_H;

struct Params {
  const float *x, *c, *ctx, *c_ctx, *w_mod, *b_mod, *norm_mix, *norm_ffn, *w_in, *w_out, *pool_w, *pool_scale;
  const float *a_re, *a_im, *log_dt, *b_re, *b_im, *c_re, *c_im, *ssm_d, *glu_w, *glu_b, *q_norm, *k_norm, *sink;
  const float *w_gate, *w_up, *w_down;
  float* out;
  char* ws;
};

DI unsigned short f2bf(float x) { unsigned u = __float_as_uint(x); u += 0x7fffu + ((u >> 16) & 1u); return (unsigned short)(u >> 16); }
DI float bf2f(unsigned short h) { return __uint_as_float(((unsigned)h) << 16); }
DI unsigned pack2(float a, float b) { unsigned r; asm("v_cvt_pk_bf16_f32 %0, %1, %2\n\ts_nop 1" : "=v"(r) : "v"(a), "v"(b)); return r; }
DI float bflo(unsigned u) { return __uint_as_float(u << 16); }
DI float bfhi(unsigned u) { return __uint_as_float(u & 0xffff0000u); }
DI int otid() { int t = threadIdx.x; asm volatile("" : "+v"(t)); return t; }
DI float frcp(float x) { return __builtin_amdgcn_rcpf(x); }
DI int crow32(int i, int h) { return (i & 3) + 8 * (i >> 2) + 4 * h; }

DI void sincos_d(double x, double* sn, double* cs) {
  const double kd = rint(x * 0.6366197723675814);
  double r = fma(-kd, 1.5707963267948966, x);
  r = fma(-kd, 6.123233995736766e-17, r);
  const int k = ((int)kd) & 3;
  const double r2 = r * r;
  const double sp = r + r * r2 * (-1.0 / 6 + r2 * (1.0 / 120 + r2 * (-1.0 / 5040 + r2 * (1.0 / 362880 + r2 * (-1.0 / 39916800 + r2 * (1.0 / 6227020800.0 + r2 * (-1.0 / 1307674368000.0)))))));
  const double cp = 1.0 + r2 * (-0.5 + r2 * (1.0 / 24 + r2 * (-1.0 / 720 + r2 * (1.0 / 40320 + r2 * (-1.0 / 3628800 + r2 * (1.0 / 479001600 + r2 * (-1.0 / 87178291200.0)))))));
  const double s0 = (k & 1) ? cp : sp, c0 = (k & 1) ? sp : cp;
  *sn = (k & 2) ? -s0 : s0;
  *cs = ((k + 1) & 2) ? -c0 : c0;
}
DI void pro_ssm(const Params& P, int item, char* smem) {
  const int tid = otid();
  const int tb = item >> 2, qt = item & 3;
  const int l = tb >> 5, g = (tb >> 1) & 15, dir = tb & 1;
  const int ig = (l * 2 + dir) * 16 + g;
  float2* apow = (float2*)smem;
  float2* bbar = apow + 65 * 64;
  float2* cm = bbar + 64 * 16;
  const double dt = exp((double)P.log_dt[ig]);
  {
    const int p = tid & 63;
    const double lre = fmin((double)P.a_re[ig * 64 + p], -1e-4), lim = (double)P.a_im[ig * 64 + p];
#pragma unroll 1
    for (int e = tid >> 6; e <= 64; e += 4) {
      double mag = exp(lre * dt * (double)e), sn, cs;
      sincos_d(lim * dt * (double)e, &sn, &cs);
      apow[e * 64 + p] = make_float2((float)(mag * cs), (float)(mag * sn));
    }
  }
#pragma unroll 1
  for (int i = 0; i < 4; ++i) {
    const int idx = tid + 256 * i, p = idx >> 4, c = idx & 15;
    const double lre = fmin((double)P.a_re[ig * 64 + p], -1e-4), lim = (double)P.a_im[ig * 64 + p];
    double mag = exp(lre * dt), sn, cs;
    sincos_d(lim * dt, &sn, &cs);
    const double nre = mag * cs - 1.0, nim = mag * sn;
    const double den = lre * lre + lim * lim;
    const double cre = (nre * lre + nim * lim) / den, cim = (nim * lre - nre * lim) / den;
    const double bre = (double)P.b_re[(size_t)(ig * 64 + p) * 16 + c], bim = (double)P.b_im[(size_t)(ig * 64 + p) * 16 + c];
    bbar[p * 16 + c] = make_float2((float)(cre * bre - cim * bim), (float)(cre * bim + cim * bre));
    const int c2 = idx >> 6, p2 = idx & 63;
    cm[c2 * 64 + p2] = make_float2(P.c_re[(size_t)(ig * 16 + c2) * 64 + p2], P.c_im[(size_t)(ig * 16 + c2) * 64 + p2]);
  }
  __syncthreads();
  bf16_t* KT = (bf16_t*)(P.ws + OFF_KTAB) + (size_t)tb * 16384;
  bf16_t* ET = (bf16_t*)(P.ws + OFF_ETAB) + (size_t)tb * 131072;
  bf16_t* FT = (bf16_t*)(P.ws + OFF_FTAB) + (size_t)tb * 131072;
  {
    const int ci = tid & 15, co = tid >> 4;
#pragma unroll 1
    for (int tt = 0; tt < 16; ++tt) {
      const int tau = qt * 16 + tt;
      float acc = 0.f;
#pragma unroll 4
      for (int p = 0; p < 64; ++p) {
        const float2 cc = cm[co * 64 + p], aa = apow[tau * 64 + p], bb = bbar[p * 16 + ci];
        const float xr = cc.x * aa.x - cc.y * aa.y, xi = cc.x * aa.y + cc.y * aa.x;
        acc += xr * bb.x - xi * bb.y;
      }
      KT[tau * 256 + co * 16 + ci] = f2bf(acc);
    }
  }
  {
    const int c = tid & 15, ol = tid >> 4, off = qt * 16 + ol;
    const int e = dir == 0 ? 63 - off : off;
#pragma unroll 2
    for (int p = 0; p < 64; ++p) {
      const float2 aa = apow[e * 64 + p], bb = bbar[p * 16 + c];
      ET[(size_t)p * 1024 + off * 16 + c] = f2bf(aa.x * bb.x - aa.y * bb.y);
      ET[(size_t)(64 + p) * 1024 + off * 16 + c] = f2bf(aa.x * bb.y + aa.y * bb.x);
    }
  }
  {
    const int col = tid & 127, half = tid >> 7, p = col & 63, part = col >> 6;
#pragma unroll 2
    for (int rr = 0; rr < 128; ++rr) {
      const int rowl = half * 128 + rr, off = qt * 16 + (rowl >> 4), co = rowl & 15;
      const int e = dir == 0 ? off + 1 : 64 - off;
      const float2 cc = cm[co * 64 + p], aa = apow[e * 64 + p];
      const float vr = cc.x * aa.x - cc.y * aa.y, vi = cc.x * aa.y + cc.y * aa.x;
      FT[(size_t)(off * 16 + co) * 128 + col] = f2bf(part == 0 ? vr : -vi);
    }
  }
  if (qt == 0 && tid < 64) ((float2*)(P.ws + OFF_AT))[tb * 64 + tid] = apow[64 * 64 + tid];
}

DI void pro_mod(const Params& P, int item, char* smem) {
  const int tid = otid();
  const int l = item / 96, n0 = (item % 96) * 64;
  float* sl = (float*)smem;
  float* red = sl;
  for (int i = tid; i < 9 * 1024; i += 256) {
    const int r = i >> 10, k = i & 1023;
    const float v = r < 8 ? P.c[r * 1024 + k] : P.c_ctx[k];
    sl[i] = v / (1.f + __expf(-v));
  }
  __syncthreads();
  const int kq = tid >> 4, cq = tid & 15;
  float acc[9][4];
#pragma unroll
  for (int r = 0; r < 9; ++r) { acc[r][0] = acc[r][1] = acc[r][2] = acc[r][3] = 0.f; }
  const float* wp = P.w_mod + (size_t)l * 1024 * 6144 + n0 + cq * 4;
#pragma unroll 4
  for (int i = 0; i < 64; ++i) {
    const int k = kq + 16 * i;
    const float4 w = *(const float4*)(wp + (size_t)k * 6144);
#pragma unroll
    for (int r = 0; r < 9; ++r) {
      const float s = sl[r * 1024 + k];
      acc[r][0] += s * w.x; acc[r][1] += s * w.y; acc[r][2] += s * w.z; acc[r][3] += s * w.w;
    }
  }
  __syncthreads();
#pragma unroll
  for (int r = 0; r < 9; ++r)
#pragma unroll
    for (int j = 0; j < 4; ++j) red[(kq * 9 + r) * 64 + cq * 4 + j] = acc[r][j];
  __syncthreads();
  float* MOD = (float*)(P.ws + OFF_MOD);
  for (int o = tid; o < 9 * 64; o += 256) {
    const int r = o >> 6, cc = o & 63;
    float s = P.b_mod[l * 6144 + n0 + cc];
    for (int q = 0; q < 16; ++q) s += red[(q * 9 + r) * 64 + cc];
    MOD[(size_t)(l * 9 + r) * 6144 + n0 + cc] = s;
  }
}

DI void pro_poolw(const Params& P, int item) {
  const int tid = otid();
  bf16_t* PT = (bf16_t*)(P.ws + OFF_POOLT);
  float v[16];
#pragma unroll
  for (int i = 0; i < 16; ++i) {
    const int e = item * 4096 + i * 256 + tid, lg = e >> 12, o = (e >> 6) & 63, c = e & 63;
    v[i] = P.pool_w[(size_t)lg * 4096 + c * 64 + o];
  }
#pragma unroll
  for (int i = 0; i < 16; ++i) PT[item * 4096 + i * 256 + tid] = f2bf(v[i]);
}

DI void pro_rope(const Params& P) {
  float2* R = (float2*)(P.ws + OFF_ROPE);
  for (int i = otid(); i < 1024; i += 256) {
    const int v = i >> 4, f = i & 15;
    const double inv = exp(-(double)f * (9.210340371976184 / 16.0));
    double sn, cs;
    sincos_d((double)v * inv, &sn, &cs);
    R[i] = make_float2((float)cs, (float)sn);
  }
}

DI void pro_transpose(const Params& P, int idx, char* smem) {
  const int tid = otid();
  const int l = idx / 2704;
  int r = idx % 2704;
  const float* src; bf16_t* dst; int K, N, kt, nt, rs = 16, ro = 0;
  if (r < 320) { src = P.w_in + (size_t)l * 1024 * 1280; dst = (bf16_t*)(P.ws + OFF_WIN) + l * W_IN_E; K = 1024; N = 1280; kt = r / 20; nt = r % 20; }
  else if (r < 576) { r -= 320; src = P.w_out + (size_t)l * 1024 * 1024; dst = (bf16_t*)(P.ws + OFF_WOUT) + l * W_OUT_E; K = 1024; N = 1024; kt = r / 16; nt = r % 16; }
  else if (r < 1280) { r -= 576; src = P.w_gate + (size_t)l * 1024 * 2816; dst = (bf16_t*)(P.ws + OFF_WGU) + l * W_GU_E; K = 1024; N = 2816; kt = r / 44; nt = r % 44; rs = 32; }
  else if (r < 1984) { r -= 1280; src = P.w_up + (size_t)l * 1024 * 2816; dst = (bf16_t*)(P.ws + OFF_WGU) + l * W_GU_E; K = 1024; N = 2816; kt = r / 44; nt = r % 44; rs = 32; ro = 16; }
  else if (r < 2688) { r -= 1984; src = P.w_down + (size_t)l * 2816 * 1024; dst = (bf16_t*)(P.ws + OFF_WD) + l * W_D_E; K = 2816; N = 1024; kt = r / 16; nt = r % 16; }
  else { r -= 2688; src = P.glu_w + (size_t)l * 65536; dst = (bf16_t*)(P.ws + OFF_GLUT) + l * W_GLU_E; K = 256; N = 256; kt = r / 4; nt = r % 4; }
  float* tile = (float*)smem;
  const int k0 = kt * 64, n0 = nt * 64;
  {
    const int kr = tid >> 4, nc = (tid & 15) * 4;
#pragma unroll
    for (int i = 0; i < 4; ++i) {
      const float4 v = *(const float4*)(src + (size_t)(k0 + kr + 16 * i) * N + n0 + nc);
      tile[(nc + 0) * 65 + kr + 16 * i] = v.x; tile[(nc + 1) * 65 + kr + 16 * i] = v.y;
      tile[(nc + 2) * 65 + kr + 16 * i] = v.z; tile[(nc + 3) * 65 + kr + 16 * i] = v.w;
    }
  }
  __syncthreads();
  {
    const int n = tid >> 2, kq = (tid & 3) * 16;
    const int ng = n0 + n;
    const int drow = (ng >> 4) * rs + (ng & 15) + ro;
    unsigned o[8];
#pragma unroll
    for (int j = 0; j < 8; ++j) o[j] = pack2(tile[n * 65 + kq + 2 * j], tile[n * 65 + kq + 2 * j + 1]);
    uint4* d = (uint4*)(dst + (size_t)drow * K + k0 + kq);
    d[0] = make_uint4(o[0], o[1], o[2], o[3]);
    d[1] = make_uint4(o[4], o[5], o[6], o[7]);
  }
}

DI void pro_copy(const Params& P, int item) {
  const int tid = otid();
  const size_t base = (size_t)item * 4096;
  float4* dst = (float4*)(P.ws + OFF_XRES);
#pragma unroll
  for (int i = 0; i < 4; ++i) {
    const size_t e = base + (size_t)(tid + 256 * i) * 4;
    const float4 v = e < (size_t)NLAT * DM ? *(const float4*)(P.x + e) : *(const float4*)(P.ctx + (e - (size_t)NLAT * DM));
    dst[e >> 2] = v;
  }
}

constexpr int PRO_SSM = 512, PRO_MOD = 384, PRO_TR = 10816, PRO_PW = 16;
constexpr int PRO_ITEMS = PRO_SSM + PRO_MOD + 1 + PRO_PW + PRO_TR;

DI void ph_prologue(const Params& P, char* smem) {
  for (int item = blockIdx.x; item < PRO_ITEMS; item += gridDim.x) {
    if (item < PRO_SSM) pro_ssm(P, item, smem);
    else if (item < PRO_SSM + PRO_MOD) pro_mod(P, item - PRO_SSM, smem);
    else if (item < PRO_SSM + PRO_MOD + 1) pro_rope(P);
    else if (item < PRO_SSM + PRO_MOD + 1 + PRO_PW) pro_poolw(P, item - (PRO_SSM + PRO_MOD + 1));
    else pro_transpose(P, item - (PRO_SSM + PRO_MOD + 1 + PRO_PW), smem);
    __syncthreads();
  }
}

DI void ph_norm(const Params& P, int l, int which, int nrows) {
  const bool seed = (l == 0 && which == 0);
  const int tid = otid(), lane = tid & 63, w = tid >> 6;
  float* XR = (float*)(P.ws + OFF_XRES);
  bf16_t* H = (bf16_t*)(P.ws + OFF_H);
  const float* MOD = (const float*)(P.ws + OFF_MOD);
  const float* g = (which ? P.norm_ffn : P.norm_mix) + l * 1024;
  for (int row = blockIdx.x * 4 + w; row < nrows; row += gridDim.x * 4) {
    const float4* xr = seed ? (const float4*)(row < NLAT ? P.x + (size_t)row * 1024 : P.ctx + (size_t)(row - NLAT) * 1024) : (const float4*)(XR + (size_t)row * 1024);
    float4 v[4];
    float ss = 0.f;
#pragma unroll
    for (int i = 0; i < 4; ++i) { v[i] = xr[lane + 64 * i]; ss += v[i].x * v[i].x + v[i].y * v[i].y + v[i].z * v[i].z + v[i].w * v[i].w; }
#pragma unroll
    for (int m = 32; m >= 1; m >>= 1) ss += __shfl_xor(ss, m);
    const float rstd = rsqrtf(ss * (1.f / 1024.f) + 1e-6f);
    if (seed) {
#pragma unroll
      for (int i = 0; i < 4; ++i) ((float4*)(XR + (size_t)row * 1024))[lane + 64 * i] = v[i];
    }
    const int mr = row < NLAT ? (row >> 11) : 8;
    const float* mp = MOD + (size_t)(l * 9 + mr) * 6144;
    const float* sh = mp + (which ? 3 : 0) * 1024;
    const float* sc = mp + (which ? 4 : 1) * 1024;
#pragma unroll
    for (int i = 0; i < 4; ++i) {
      const int col = (lane + 64 * i) * 4;
      const float4 gg = *(const float4*)(g + col), s1 = *(const float4*)(sc + col), s0 = *(const float4*)(sh + col);
      const float h0 = v[i].x * rstd * gg.x * (1.f + s1.x) + s0.x;
      const float h1 = v[i].y * rstd * gg.y * (1.f + s1.y) + s0.y;
      const float h2 = v[i].z * rstd * gg.z * (1.f + s1.z) + s0.z;
      const float h3 = v[i].w * rstd * gg.w * (1.f + s1.w) + s0.w;
      *(uint2*)(H + (size_t)row * 1024 + col) = make_uint2(pack2(h0, h1), pack2(h2, h3));
    }
  }
}

#define LDSAS __attribute__((address_space(3)))
DI void glds_tile(const bf16_t* gA, const bf16_t* gB, int K, int kt, bf16_t* sA, bf16_t* sB, int buf, int w, int lane) {
  const int c = (lane & 7) ^ (lane >> 3);
#pragma unroll
  for (int j = 0; j < 4; ++j) {
    const int rb = 4 * w + j, row = 8 * rb + (lane >> 3);
    const bf16_t* srcA = gA + (size_t)row * K + kt * 64 + c * 8;
    const bf16_t* srcB = gB + (size_t)row * K + kt * 64 + c * 8;
    bf16_t* dA = sA + buf * 128 * 64 + rb * 512 + lane * 8;
    bf16_t* dB = sB + buf * 128 * 64 + rb * 512 + lane * 8;
    __builtin_amdgcn_global_load_lds((const void*)srcA, (LDSAS void*)dA, 16, 0, 0);
    __builtin_amdgcn_global_load_lds((const void*)srcB, (LDSAS void*)dB, 16, 0, 0);
  }
}

template <int EPI>
DI void ph_gemm(const Params& P, int l, const bf16_t* __restrict__ A, const bf16_t* __restrict__ Bt, int M, int N, int K,
                int gidx, bool final_out, char* smem) {
  const int tid = otid(), lane = tid & 63, w = tid >> 6, wr = w >> 1, wc = w & 1, fr = lane & 15, fq = lane >> 4;
  bf16_t* sA = (bf16_t*)smem;
  bf16_t* sB = sA + 2 * 128 * 64;
  const int tm = M >> 7, tn = N >> 7, ntiles = tm * tn, nk = K >> 6;
  const int lrow = tid >> 3, lk = (tid & 7) * 8;
  const int lsw = ((tid & 7) ^ (lrow & 7)) * 8;
  auto tile_of = [&](int s_, int& m0_, int& n0_) {
    const int t = (s_ & 7) * (ntiles >> 3) + (s_ >> 3);
    const int grp = t / (8 * tn), rem = t % (8 * tn);
    m0_ = (grp * 8 + (rem & 7)) << 7; n0_ = (rem >> 3) << 7;
  };
  if ((int)blockIdx.x < ntiles) {
    int m0, n0; tile_of(blockIdx.x, m0, n0);
    glds_tile(A + (size_t)m0 * K, Bt + (size_t)n0 * K, K, 0, sA, sB, 0, w, lane);
  }
  for (int s = blockIdx.x; s < ntiles; s += gridDim.x) {
    int m0, n0; tile_of(s, m0, n0);
    const bool has_next = s + (int)gridDim.x < ntiles;
    int m0n = 0, n0n = 0;
    if (has_next) tile_of(s + gridDim.x, m0n, n0n);
    f32x4 acc[4][4];
#pragma unroll
    for (int m = 0; m < 4; ++m)
#pragma unroll
      for (int n = 0; n < 4; ++n) acc[m][n] = f32x4{0.f, 0.f, 0.f, 0.f};
    const bf16_t* gA = A + (size_t)m0 * K;
    const bf16_t* gB = Bt + (size_t)n0 * K;
    asm volatile("s_waitcnt vmcnt(0)" ::: "memory");
    __syncthreads();
    for (int kt = 0; kt < nk; ++kt) {
      const int cur = kt & 1;
      if (kt + 1 < nk) glds_tile(gA, gB, K, kt + 1, sA, sB, cur ^ 1, w, lane);
      else if (has_next) glds_tile(A + (size_t)m0n * K, Bt + (size_t)n0n * K, K, 0, sA, sB, 0, w, lane);
      const bf16_t* cA = sA + cur * 128 * 64 + (wr * 64 + fr) * 64;
      const bf16_t* cB = sB + cur * 128 * 64 + (wc * 64 + fr) * 64;
#pragma unroll
      for (int ks = 0; ks < 2; ++ks) {
        bf16x8 af[4], bfr[4];
#pragma unroll
        for (int m = 0; m < 4; ++m) af[m] = *(const bf16x8*)(cA + m * 16 * 64 + (((ks * 4 + fq) ^ (fr & 7)) * 8));
#pragma unroll
        for (int n = 0; n < 4; ++n) bfr[n] = *(const bf16x8*)(cB + n * 16 * 64 + (((ks * 4 + fq) ^ (fr & 7)) * 8));
        __builtin_amdgcn_s_setprio(1);
#pragma unroll
        for (int m = 0; m < 4; ++m)
#pragma unroll
          for (int n = 0; n < 4; ++n) acc[m][n] = MFMA16(bfr[n], af[m], acc[m][n]);
        __builtin_amdgcn_s_setprio(0);
      }
      if (kt + 1 < nk) {
        asm volatile("s_waitcnt vmcnt(0)" ::: "memory");
        __syncthreads();
      }
    }
    if (EPI == 0) {
      bf16_t* C = (bf16_t*)(P.ws + OFF_PROJ);
      const int col0 = n0 + wc * 64;
      if (col0 >= 512 && col0 < 1152) {
        const bool isq = col0 < 1024;
        const float* nw = (isq ? P.q_norm : P.k_norm) + l * 64 + fq * 4;
        const float2* ROPE = (const float2*)(P.ws + OFF_ROPE);
        float nwv[4][4];
#pragma unroll
        for (int n = 0; n < 4; ++n)
#pragma unroll
          for (int j = 0; j < 4; ++j) nwv[n][j] = nw[n * 16 + j];
#pragma unroll
        for (int m = 0; m < 4; ++m) {
          float ss = 0.f;
#pragma unroll
          for (int n = 0; n < 4; ++n)
#pragma unroll
            for (int j = 0; j < 4; ++j) ss += acc[m][n][j] * acc[m][n][j];
          ss += __shfl_xor(ss, 16);
          ss += __shfl_xor(ss, 32);
          const float rs = rsqrtf(ss * (1.f / 64.f) + 1e-6f) * (isq ? 0.125f * 1.4426950408889634f : 1.f);
#pragma unroll
          for (int n = 0; n < 4; ++n)
#pragma unroll
            for (int j = 0; j < 4; ++j) acc[m][n][j] *= rs * nwv[n][j];
          const int row = m0 + wr * 64 + m * 16 + fr;
          if (row < NLAT) {
            const int t = row & 2047;
#pragma unroll
            for (int a = 0; a < 2; ++a) {
              const int v = a == 0 ? (t >> 6) : (t & 63);
#pragma unroll
              for (int j = 0; j < 4; ++j) {
                const float2 cssn = ROPE[v * 16 + fq * 4 + j];
                const float x1 = acc[m][2 * a][j], x2 = acc[m][2 * a + 1][j];
                acc[m][2 * a][j] = x1 * cssn.x - x2 * cssn.y;
                acc[m][2 * a + 1][j] = x2 * cssn.x + x1 * cssn.y;
              }
            }
          }
        }
      }
      if (col0 >= 1152) {
        bf16_t* VT = (bf16_t*)(P.ws + OFF_VT);
#pragma unroll
        for (int m = 0; m < 4; ++m) {
          const int row = m0 + wr * 64 + m * 16 + fr;
#pragma unroll
          for (int n = 0; n < 4; ++n)
#pragma unroll
            for (int j = 0; j < 4; ++j) VT[(size_t)(col0 - 1152 + n * 16 + fq * 4 + j) * NROW + row] = f2bf(acc[m][n][j]);
        }
      } else {
#pragma unroll
        for (int m = 0; m < 4; ++m) {
          const int row = m0 + wr * 64 + m * 16 + fr;
#pragma unroll
          for (int n = 0; n < 4; ++n) {
            const int col = col0 + n * 16 + fq * 4;
            *(uint2*)(C + (size_t)row * N + col) = make_uint2(pack2(acc[m][n][0], acc[m][n][1]), pack2(acc[m][n][2], acc[m][n][3]));
          }
        }
      }
    } else if (EPI == 1) {
      float* XR = (float*)(P.ws + OFF_XRES);
      const float* MOD = (const float*)(P.ws + OFF_MOD);
      const int mr = m0 < NLAT ? (m0 >> 11) : 8;
      const float* gp = MOD + (size_t)(l * 9 + mr) * 6144 + gidx * 1024 + n0 + wc * 64 + fq * 4;
      float4 gg[4];
#pragma unroll
      for (int n = 0; n < 4; ++n) gg[n] = *(const float4*)(gp + n * 16);
      float* xbase = XR + (size_t)(m0 + wr * 64 + fr) * 1024 + n0 + wc * 64 + fq * 4;
      float4 xv[4][4];
#pragma unroll
      for (int m = 0; m < 4; ++m)
#pragma unroll
        for (int n = 0; n < 4; ++n) xv[m][n] = *(const float4*)(xbase + (size_t)m * 16 * 1024 + n * 16);
      float* obase = final_out ? P.out + (size_t)(m0 + wr * 64 + fr) * 1024 + n0 + wc * 64 + fq * 4 : xbase;
#pragma unroll
      for (int m = 0; m < 4; ++m)
#pragma unroll
        for (int n = 0; n < 4; ++n) {
          float4 o;
          o.x = xv[m][n].x + gg[n].x * acc[m][n][0]; o.y = xv[m][n].y + gg[n].y * acc[m][n][1];
          o.z = xv[m][n].z + gg[n].z * acc[m][n][2]; o.w = xv[m][n].w + gg[n].w * acc[m][n][3];
          *(float4*)(obase + (size_t)m * 16 * 1024 + n * 16) = o;
        }
    } else {
      bf16_t* ACT = (bf16_t*)(P.ws + OFF_ACT);
#pragma unroll
      for (int m = 0; m < 4; ++m) {
        const int row = m0 + wr * 64 + m * 16 + fr;
#pragma unroll
        for (int i = 0; i < 2; ++i) {
          const int col = (n0 >> 1) + wc * 32 + i * 16 + fq * 4;
          float o[4];
#pragma unroll
          for (int j = 0; j < 4; ++j) { const float gt = acc[m][2 * i][j], up = acc[m][2 * i + 1][j]; o[j] = gt * frcp(1.f + __expf(-gt)) * up; }
          *(uint2*)(ACT + (size_t)row * DFF + col) = make_uint2(pack2(o[0], o[1]), pack2(o[2], o[3]));
        }
      }
    }
  }
}

DI void attn_item(const Params& P, int l, int item, char* smem) {
  const int tid = otid(), lane = tid & 63, w = tid >> 6, r = lane & 31, h = lane >> 5;
  bf16_t* sK = (bf16_t*)smem;
  bf16_t* sV = sK + 32 * 72;
  const bf16_t* PROJ = (const bf16_t*)(P.ws + OFF_PROJ);
  bf16_t* CAT = (bf16_t*)(P.ws + OFF_CAT);
  const bool ctxq = item >= 512;
  int b, kvh, qb;
  if (!ctxq) { b = item >> 6; kvh = (item >> 5) & 1; qb = item & 31; }
  else { const int it = item - 512; b = it >> 3; kvh = (it >> 2) & 1; qb = it & 3; }
  const int q0 = qb * 64, head = kvh * 4 + w;
  const int qrow0 = (ctxq ? NLAT + b * 256 : b * 2048) + q0 + r;
  bf16x8 qf[2][4];
#pragma unroll
  for (int u = 0; u < 2; ++u) {
    const bf16_t* qptr = PROJ + (size_t)(qrow0 + 32 * u) * INW + 512 + head * 64 + 8 * h;
#pragma unroll
    for (int s = 0; s < 4; ++s) qf[u][s] = *(const bf16x8*)(qptr + 16 * s);
  }
  int i_lo = 0, nwin = 0;
  if (!ctxq) {
    i_lo = q0 < 128 ? (128 - q0) >> 5 : 0;
    int i_hi = (2144 - q0) >> 5; if (i_hi > 9) i_hi = 9;
    nwin = i_hi - i_lo + 1;
  }
  const int nt = nwin + 8;
  const int key = tid >> 3, t8 = tid & 7;
  const int vd = tid >> 2, vc = tid & 3;
  const bf16_t* VT = (const bf16_t*)(P.ws + OFF_VT) + (size_t)(kvh * 64 + vd) * NROW + vc * 8;
  const float sink2 = P.sink[l * 8 + head] * 1.4426950408889634f;
  float m_run[2] = {sink2, sink2};
  float l_run[2] = {h == 0 ? 1.f : 0.f, h == 0 ? 1.f : 0.f};
  f32x16 oacc[2][2];
#pragma unroll
  for (int i = 0; i < 16; ++i) { oacc[0][0][i] = 0.f; oacc[0][1][i] = 0.f; oacc[1][0][i] = 0.f; oacc[1][1][i] = 0.f; }
  auto tile_row0 = [&](int t) -> size_t {
    const bool kc = t >= nwin;
    const int start = kc ? 32 * (t - nwin) : q0 - 128 + 32 * (i_lo + t);
    return (size_t)((kc ? NLAT + b * 256 : b * 2048) + start);
  };
  auto tile_load = [&](int t, uint4& kr, uint4& vr) {
    if (t < nt) {
      const size_t krow0 = tile_row0(t);
      kr = *(const uint4*)(PROJ + (krow0 + key) * INW + 1024 + kvh * 64 + t8 * 8);
      vr = *(const uint4*)(VT + krow0);
    }
  };
  uint4 kr0, kr1, kr2, kr3, vr0, vr1, vr2, vr3;
  kr0 = kr1 = kr2 = kr3 = vr0 = vr1 = vr2 = vr3 = make_uint4(0u, 0u, 0u, 0u);
  tile_load(0, kr0, vr0); tile_load(1, kr1, vr1); tile_load(2, kr2, vr2); tile_load(3, kr3, vr3);
  constexpr int TILE_E = 32 * 72 + 64 * 40;
  *(uint4*)(sK + key * 72 + t8 * 8) = kr0;
  *(uint4*)(sV + vd * 40 + vc * 8) = vr0;
  tile_load(4, kr0, vr0);
  __syncthreads();
  auto tile_step = [&](int t, uint4& knext, uint4& vnext) {
    const bool kc = t >= nwin;
    const int start = kc ? 32 * (t - nwin) : q0 - 128 + 32 * (i_lo + t);
    if (t + 1 < nt) {
      bf16_t* nb = sK + ((t + 1) & 1) * TILE_E;
      *(uint4*)(nb + key * 72 + t8 * 8) = knext;
      *(uint4*)(nb + 32 * 72 + vd * 40 + vc * 8) = vnext;
      tile_load(t + 5, knext, vnext);
    }
    const bf16_t* sKc = sK + (t & 1) * TILE_E;
    const bf16_t* sVc = sKc + 32 * 72;
    bf16x8 kf[4];
#pragma unroll
    for (int s = 0; s < 4; ++s) kf[s] = *(const bf16x8*)(sKc + r * 72 + 16 * s + 8 * h);
    bf16x8 pf[2][2];
#pragma unroll
    for (int u = 0; u < 2; ++u) {
      f32x16 sacc;
#pragma unroll
      for (int i = 0; i < 16; ++i) sacc[i] = 0.f;
#pragma unroll
      for (int s = 0; s < 4; ++s) sacc = MFMA32(kf[s], qf[u][s], sacc);
      const int q0u = q0 + 32 * u;
      if (!kc && (start < q0u - 97 || start > q0u + 97)) {
#pragma unroll
        for (int i = 0; i < 16; ++i) {
          const int d = start + crow32(i, h) - (q0u + r);
          if (d > 128 || d < -128) sacc[i] = -INFINITY;
        }
      }
      float mx = -INFINITY;
#pragma unroll
      for (int i = 0; i < 16; ++i) mx = fmaxf(mx, sacc[i]);
      mx = fmaxf(mx, __shfl_xor(mx, 32));
      const float m_new = fmaxf(m_run[u], mx);
      const float alpha = __builtin_amdgcn_exp2f(m_run[u] - m_new);
      m_run[u] = m_new;
      float psum = 0.f;
#pragma unroll
      for (int i = 0; i < 16; ++i) { sacc[i] = __builtin_amdgcn_exp2f(sacc[i] - m_new); psum += sacc[i]; }
      l_run[u] = l_run[u] * alpha + psum;
#pragma unroll
      for (int i = 0; i < 16; ++i) { oacc[u][0][i] *= alpha; oacc[u][1][i] *= alpha; }
#pragma unroll
      for (int s2 = 0; s2 < 2; ++s2)
        pf[u][s2] = __builtin_bit_cast(bf16x8, make_uint4(pack2(sacc[8 * s2 + 0], sacc[8 * s2 + 1]), pack2(sacc[8 * s2 + 2], sacc[8 * s2 + 3]),
                                                           pack2(sacc[8 * s2 + 4], sacc[8 * s2 + 5]), pack2(sacc[8 * s2 + 6], sacc[8 * s2 + 7])));
    }
#pragma unroll
    for (int db = 0; db < 2; ++db)
#pragma unroll
      for (int s2 = 0; s2 < 2; ++s2) {
        const bf16_t* vrow = sVc + (32 * db + r) * 40 + 16 * s2 + 4 * h;
        const uint2 lo = *(const uint2*)(vrow), hi = *(const uint2*)(vrow + 8);
        const bf16x8 vf = __builtin_bit_cast(bf16x8, make_uint4(lo.x, lo.y, hi.x, hi.y));
        oacc[0][db] = MFMA32(vf, pf[0][s2], oacc[0][db]);
        oacc[1][db] = MFMA32(vf, pf[1][s2], oacc[1][db]);
      }
    __syncthreads();
  };
  for (int t0 = 0; t0 < nt; t0 += 4) {
    tile_step(t0, kr1, vr1);
    if (t0 + 1 < nt) tile_step(t0 + 1, kr2, vr2);
    if (t0 + 2 < nt) tile_step(t0 + 2, kr3, vr3);
    if (t0 + 3 < nt) tile_step(t0 + 3, kr0, vr0);
  }
#pragma unroll
  for (int u = 0; u < 2; ++u) {
    const float ltot = l_run[u] + __shfl_xor(l_run[u], 32);
    const float inv = frcp(ltot);
    bf16_t* op = CAT + (size_t)(qrow0 + 32 * u) * 1024 + 512 + head * 64;
#pragma unroll
    for (int db = 0; db < 2; ++db)
#pragma unroll
      for (int g4 = 0; g4 < 4; ++g4) {
        const int d = 32 * db + 8 * g4 + 4 * h;
        *(uint2*)(op + d) = make_uint2(pack2(oacc[u][db][4 * g4 + 0] * inv, oacc[u][db][4 * g4 + 1] * inv),
                                       pack2(oacc[u][db][4 * g4 + 2] * inv, oacc[u][db][4 * g4 + 3] * inv));
      }
  }
}

template <int HALF>
DI void pool_diffs(const float (&u)[48], bf16_t* sd, int tid, int t0, int Lseq) {
  float s = 0.f;
#pragma unroll
  for (int i = 8 - HALF; i < 8 + HALF; ++i) s += u[i];
#pragma unroll
  for (int tt = 0; tt < 32; ++tt) {
    if (tt > 0) s += u[8 + tt + HALF - 1] - u[8 + tt - HALF - 1];
    const int t = t0 + tt;
    const int cnt = min(t + HALF, Lseq) - max(t - HALF, 0);
    sd[tt * 264 + tid] = f2bf(s * frcp((float)cnt) - u[8 + tt]);
  }
}

DI void pool_item(const Params& P, int l, int item, char* smem) {
  const int tid = otid();
  bf16_t* sd = (bf16_t*)smem;
  const bf16_t* PROJ = (const bf16_t*)(P.ws + OFF_PROJ);
  bf16_t* CAT = (bf16_t*)(P.ws + OFF_CAT);
  const int row0 = item * 32;
  const int seqstart = row0 < NLAT ? (row0 & ~2047) : NLAT + ((row0 - NLAT) & ~255);
  const int Lseq = row0 < NLAT ? 2048 : 256;
  const int t0 = row0 - seqstart;
  const int gi = __builtin_amdgcn_readfirstlane(tid >> 6);
  {
    float u[48];
#pragma unroll
    for (int i = 0; i < 48; ++i) {
      const int t = t0 - 8 + i;
      const int tc = min(max(t, 0), Lseq - 1);
      const float v = bf2f(PROJ[(size_t)(seqstart + tc) * INW + tid]);
      u[i] = (t >= 0 && t < Lseq) ? v : 0.f;
    }
    if (gi == 0) pool_diffs<1>(u, sd, tid, t0, Lseq);
    else if (gi == 1) pool_diffs<2>(u, sd, tid, t0, Lseq);
    else if (gi == 2) pool_diffs<4>(u, sd, tid, t0, Lseq);
    else pool_diffs<8>(u, sd, tid, t0, Lseq);
  }
  const int lane = tid & 63, fr = lane & 15, fq = lane >> 4;
  const bf16_t* wt = (const bf16_t*)(P.ws + OFF_POOLT) + (size_t)(l * 4 + gi) * 4096 + (size_t)fr * 64 + fq * 8;
  bf16x8 bfr[2][4];
#pragma unroll
  for (int ks = 0; ks < 2; ++ks)
#pragma unroll
    for (int n = 0; n < 4; ++n) bfr[ks][n] = *(const bf16x8*)(wt + n * 16 * 64 + ks * 32);
  float4 sc4[4];
#pragma unroll
  for (int n = 0; n < 4; ++n) sc4[n] = *(const float4*)(P.pool_scale + l * 256 + gi * 64 + n * 16 + fq * 4);
  __syncthreads();
  f32x4 acc[2][4];
#pragma unroll
  for (int m = 0; m < 2; ++m)
#pragma unroll
    for (int n = 0; n < 4; ++n) acc[m][n] = f32x4{0.f, 0.f, 0.f, 0.f};
#pragma unroll
  for (int ks = 0; ks < 2; ++ks) {
    bf16x8 af[2];
#pragma unroll
    for (int m = 0; m < 2; ++m) af[m] = *(const bf16x8*)(sd + (m * 16 + fr) * 264 + gi * 64 + ks * 32 + fq * 8);
#pragma unroll
    for (int m = 0; m < 2; ++m)
#pragma unroll
      for (int n = 0; n < 4; ++n) acc[m][n] = MFMA16(bfr[ks][n], af[m], acc[m][n]);
  }
#pragma unroll
  for (int m = 0; m < 2; ++m)
#pragma unroll
    for (int n = 0; n < 4; ++n)
      *(uint2*)(CAT + (size_t)(row0 + m * 16 + fr) * 1024 + gi * 64 + n * 16 + fq * 4) =
          make_uint2(pack2(acc[m][n][0] * sc4[n].x, acc[m][n][1] * sc4[n].y), pack2(acc[m][n][2] * sc4[n].z, acc[m][n][3] * sc4[n].w));
}

DI int chunk_rowbase(int b, int kap) { return kap < 4 ? NLAT + b * 256 + kap * 64 : b * 2048 + (kap - 4) * 64; }

DI void ssm1_item(const Params& P, int l, int item) {
  const int tid = otid(), lane = tid & 63, w = tid >> 6, n = lane & 15, q = lane >> 4;
  const int g = item / 36, dir = (item / 18) & 1, cb = item % 18;
  const int tb = (l * 16 + g) * 2 + dir;
  const int col = cb * 16 + n, b = col / 36, kap = col % 36;
  const bf16_t* up = (const bf16_t*)(P.ws + OFF_PROJ) + (size_t)chunk_rowbase(b, kap) * INW + 256 + g * 16 + 8 * (q & 1) + (size_t)(q >> 1) * INW;
  const bf16_t* ep = (const bf16_t*)(P.ws + OFF_ETAB) + (size_t)tb * 131072 + (size_t)((2 * w) * 16 + n) * 1024 + 8 * q;
  f32x4 acc0 = {0.f, 0.f, 0.f, 0.f}, acc1 = {0.f, 0.f, 0.f, 0.f};
#pragma unroll 8
  for (int ks = 0; ks < 32; ++ks) {
    const bf16x8 bq = *(const bf16x8*)(up + (size_t)(2 * ks) * INW);
    const bf16x8 a0 = *(const bf16x8*)(ep + ks * 32);
    const bf16x8 a1 = *(const bf16x8*)(ep + 16 * 1024 + ks * 32);
    acc0 = MFMA16(a0, bq, acc0);
    acc1 = MFMA16(a1, bq, acc1);
  }
  float* SL = (float*)(P.ws + OFF_SLOC) + ((size_t)((b * 16 + g) * 2 + dir) * 36 + kap) * 128;
  *(float4*)(SL + (2 * w) * 16 + 4 * q) = make_float4(acc0[0], acc0[1], acc0[2], acc0[3]);
  *(float4*)(SL + (2 * w + 1) * 16 + 4 * q) = make_float4(acc1[0], acc1[1], acc1[2], acc1[3]);
}

DI void ssm3_item(const Params& P, int l, int item, char* smem) {
  const int tid = otid(), lane = tid & 63, w = tid >> 6, n = lane & 15, q = lane >> 4;
  const int g = item / 36, dir = (item / 18) & 1, cb = item % 18;
  const int tb = (l * 16 + g) * 2 + dir;
  bf16_t* sst = (bf16_t*)smem;
  bf16_t* sK = sst + 16 * 128;
  char* sU = (char*)(sK + 64 * 256);
  const bf16_t* PROJ = (const bf16_t*)(P.ws + OFF_PROJ);
  struct U8 { uint4 v0, v1, v2, v3, v4, v5, v6, v7; };
  U8 ureg;
  const int bsel = tid >> 6, sp = tid & 63;
  const int bs_raw = (cb * 16) / 36 + bsel;
  const bool scan_on = tid < 128 && bs_raw <= (cb * 16 + 15) / 36;
  const int bs = scan_on ? bs_raw : (cb * 16) / 36;
  float lr[36], li[36];
  {
    const uint4* src = (const uint4*)((const bf16_t*)(P.ws + OFF_KTAB) + (size_t)tb * 16384) + tid;
    uint4 k0 = src[0], k1 = src[256], k2 = src[512], k3 = src[768], k4 = src[1024], k5 = src[1280], k6 = src[1536], k7 = src[1792];
    const float* SL = (const float*)(P.ws + OFF_SLOC) + (size_t)((bs * 16 + g) * 2 + dir) * 36 * 128 + sp;
#pragma unroll
    for (int step = 0; step < 36; ++step) {
      const int kap = dir == 0 ? step : (step < 4 ? 3 - step : 39 - step);
      lr[step] = SL[kap * 128]; li[step] = SL[kap * 128 + 64];
    }
    auto uload = [&](int i, int hf) {
      const int idx = tid + 256 * i, row = idx >> 1, half = idx & 1, nn = row >> 5, off = (row & 31) + 32 * hf;
      const int colg = cb * 16 + nn;
      return *(const uint4*)(PROJ + (size_t)(chunk_rowbase(colg / 36, colg % 36) + off) * INW + 256 + g * 16 + half * 8);
    };
    ureg.v0 = uload(0, 0); ureg.v1 = uload(1, 0); ureg.v2 = uload(2, 0); ureg.v3 = uload(3, 0);
    ureg.v4 = uload(0, 1); ureg.v5 = uload(1, 1); ureg.v6 = uload(2, 1); ureg.v7 = uload(3, 1);
    uint4* d = (uint4*)sK + tid;
    d[0] = k0; d[256] = k1; d[512] = k2; d[768] = k3; d[1024] = k4; d[1280] = k5; d[1536] = k6; d[1792] = k7;
  }
  if (scan_on) {
    const float2 aT = ((const float2*)(P.ws + OFF_AT))[tb * 64 + sp];
    float sr = 0.f, si = 0.f;
#pragma unroll
    for (int step = 0; step < 36; ++step) {
      const int kap = dir == 0 ? step : (step < 4 ? 3 - step : 39 - step);
      const int nloc = bs * 36 + kap - cb * 16;
      if (nloc >= 0 && nloc < 16) { sst[nloc * 128 + sp] = f2bf(sr); sst[nloc * 128 + 64 + sp] = f2bf(si); }
      const float nr = aT.x * sr - aT.y * si + lr[step], ni = aT.x * si + aT.y * sr + li[step];
      sr = nr; si = ni;
    }
  }
  const bf16_t* FT = (const bf16_t*)(P.ws + OFF_FTAB) + (size_t)tb * 131072 + (size_t)n * 128 + 8 * q;
  float* Y = (float*)(P.ws + OFF_YSSM) + (size_t)(dir * 16 + g) * NROW * 16;
  const bf16x8 zero8 = {0, 0, 0, 0, 0, 0, 0, 0};
  {
    const int colg = cb * 16 + n;
    const bool valid = true;
    const int kapc = n;
    const int rowbase = chunk_rowbase(colg / 36, colg % 36);
    f32x4 acc[16];
#pragma unroll
    for (int oi = 0; oi < 16; ++oi) acc[oi] = f32x4{0.f, 0.f, 0.f, 0.f};
    const char* ub = sU + n * 1056 + (q >> 1) * 32 + (q & 1) * 16;
    const char* kb = (const char*)sK + n * 32 + (q & 1) * 16;
    const int wu = __builtin_amdgcn_readfirstlane(w);
    auto half_body = [&](const int hf, const uint4 u0, const uint4 u1, const uint4 u2, const uint4 u3) {
      __syncthreads();
      {
        const int r0 = tid >> 1, h0 = tid & 1;
        char* d = sU + (r0 >> 5) * 1056 + (r0 & 31) * 32 + h0 * 16;
        *(uint4*)(d) = u0; *(uint4*)(d + 4 * 1056) = u1; *(uint4*)(d + 8 * 1056) = u2; *(uint4*)(d + 12 * 1056) = u3;
      }
      __syncthreads();
#pragma unroll
      for (int G = 0; G < 4; ++G) {
        int ks_lo = dir == 0 ? 0 : ((wu + 16 * G) >> 1);
        int ks_hi = dir == 0 ? ((wu + 16 * G + 12) >> 1) : 31;
        ks_lo = max(ks_lo, 16 * hf);
        ks_hi = min(ks_hi, 16 * hf + 15);
#pragma unroll 2
        for (int ks = ks_lo; ks <= ks_hi; ++ks) {
          const bf16x8 bq = *(const bf16x8*)(ub + (ks - 16 * hf) * 64);
          const int off_in = 2 * ks + (q >> 1);
#pragma unroll
          for (int i = 0; i < 4; ++i) {
            const int off_out = w + 16 * G + 4 * i;
            const int tau = dir == 0 ? off_out - off_in : off_in - off_out;
            const int tc = tau < 0 ? 0 : tau;
            bf16x8 a = *(const bf16x8*)(kb + tc * 512);
            if (tau < 0) a = zero8;
            acc[4 * G + i] = MFMA16(a, bq, acc[4 * G + i]);
          }
        }
      }
    };
    half_body(0, ureg.v0, ureg.v1, ureg.v2, ureg.v3);
    half_body(1, ureg.v4, ureg.v5, ureg.v6, ureg.v7);
    bf16x8 sb[4];
#pragma unroll
    for (int k2 = 0; k2 < 4; ++k2) sb[k2] = *(const bf16x8*)(sst + kapc * 128 + k2 * 32 + 8 * q);
#pragma unroll
    for (int oh = 0; oh < 2; ++oh) {
      bf16x8 fa[8][4];
#pragma unroll
      for (int o2 = 0; o2 < 8; ++o2)
#pragma unroll
        for (int k2 = 0; k2 < 4; ++k2) fa[o2][k2] = *(const bf16x8*)(FT + (size_t)(w + 4 * (8 * oh + o2)) * 16 * 128 + k2 * 32);
#pragma unroll
      for (int o2 = 0; o2 < 8; ++o2)
#pragma unroll
        for (int k2 = 0; k2 < 4; ++k2) acc[8 * oh + o2] = MFMA16(fa[o2][k2], sb[k2], acc[8 * oh + o2]);
    }
    if (valid) {
#pragma unroll
      for (int oi = 0; oi < 16; ++oi)
        *(float4*)(Y + (size_t)(rowbase + w + 4 * oi) * 16 + 4 * q) = make_float4(acc[oi][0], acc[oi][1], acc[oi][2], acc[oi][3]);
    }
  }
}

DI void glu_item(const Params& P, int l, int item, char* smem) {
  const int tid = otid(), lane = tid & 63, w = tid >> 6, fr = lane & 15, fq = lane >> 4;
  bf16_t* sG = (bf16_t*)smem;
  const int row0 = item * 64;
  const bf16_t* PROJ = (const bf16_t*)(P.ws + OFF_PROJ);
  const float* Y0 = (const float*)(P.ws + OFF_YSSM);
  const float* Y1 = Y0 + (size_t)NROW * 256;
  bf16_t* CAT = (bf16_t*)(P.ws + OFF_CAT);
#pragma unroll 4
  for (int i = 0; i < 16; ++i) {
    const int rr = tid >> 2, c4 = i * 16 + (tid & 3) * 4;
    const size_t row = (size_t)(row0 + rr);
    const float4 a = *(const float4*)(Y0 + ((size_t)i * NROW + row) * 16 + (tid & 3) * 4), bb = *(const float4*)(Y1 + ((size_t)i * NROW + row) * 16 + (tid & 3) * 4);
    const float4 dd = *(const float4*)(P.ssm_d + l * 256 + c4);
    const uint2 ur = *(const uint2*)(PROJ + row * INW + 256 + c4);
    float y[4] = {dd.x * bflo(ur.x) + a.x + bb.x, dd.y * bfhi(ur.x) + a.y + bb.y, dd.z * bflo(ur.y) + a.z + bb.z, dd.w * bfhi(ur.y) + a.w + bb.w};
#pragma unroll
    for (int j = 0; j < 4; ++j) {
      const float v = y[j];
      const float u = 0.7978845608028654f * (v + 0.044715f * v * v * v);
      const float th = 1.f - 2.f * frcp(1.f + __expf(2.f * u));
      y[j] = 0.5f * v * (1.f + th);
    }
    *(uint2*)(sG + rr * 264 + c4) = make_uint2(pack2(y[0], y[1]), pack2(y[2], y[3]));
  }
  __syncthreads();
  f32x4 acc[4][4];
#pragma unroll
  for (int m = 0; m < 4; ++m)
#pragma unroll
    for (int nn = 0; nn < 4; ++nn) acc[m][nn] = f32x4{0.f, 0.f, 0.f, 0.f};
  const bf16_t* GT = (const bf16_t*)(P.ws + OFF_GLUT) + (size_t)l * 65536 + (size_t)(w * 64 + fr) * 256 + fq * 8;
#pragma unroll 4
  for (int ks = 0; ks < 8; ++ks) {
    bf16x8 af[4], bfr[4];
#pragma unroll
    for (int m = 0; m < 4; ++m) af[m] = *(const bf16x8*)(sG + (m * 16 + fr) * 264 + ks * 32 + fq * 8);
#pragma unroll
    for (int nn = 0; nn < 4; ++nn) bfr[nn] = *(const bf16x8*)(GT + (size_t)nn * 16 * 256 + ks * 32);
#pragma unroll
    for (int m = 0; m < 4; ++m)
#pragma unroll
      for (int nn = 0; nn < 4; ++nn) acc[m][nn] = MFMA16(bfr[nn], af[m], acc[m][nn]);
  }
#pragma unroll
  for (int m = 0; m < 4; ++m) {
    const int rr = m * 16 + fr;
#pragma unroll
    for (int nn = 0; nn < 4; ++nn) {
      const int col = w * 64 + nn * 16 + fq * 4;
      const float4 gb = *(const float4*)(P.glu_b + l * 256 + col);
      const uint2 gr = *(const uint2*)(sG + rr * 264 + col);
      const float z0 = acc[m][nn][0] + gb.x, z1 = acc[m][nn][1] + gb.y, z2 = acc[m][nn][2] + gb.z, z3 = acc[m][nn][3] + gb.w;
      const float o0 = bflo(gr.x) * frcp(1.f + __expf(-z0)), o1 = bfhi(gr.x) * frcp(1.f + __expf(-z1));
      const float o2 = bflo(gr.y) * frcp(1.f + __expf(-z2)), o3 = bfhi(gr.y) * frcp(1.f + __expf(-z3));
      *(uint2*)(CAT + (size_t)(row0 + rr) * 1024 + 256 + col) = make_uint2(pack2(o0, o1), pack2(o2, o3));
    }
  }
}

#define XB_TMO      128
#define XB_XCNT(j)  (256  + 64 * (j))
#define XB_XSUB(j)  (1280 + 64 * (j))
#define XB_XGEN(j)  (2304 + 64 * (j))
#define XB_TOP      3328
#define XB_TOPGEN   3392
#define XCD_BAR_WORDS 3456
#define XB_SPIN_CAP (1u << 21)
#define LAS __attribute__((address_space(3)))

__device__ __forceinline__ unsigned xb_ld(unsigned* p)              { return __hip_atomic_load(p, __ATOMIC_RELAXED, __HIP_MEMORY_SCOPE_AGENT); }
__device__ __forceinline__ unsigned xb_add(unsigned* p, unsigned v) { return __hip_atomic_fetch_add(p, v, __ATOMIC_RELAXED, __HIP_MEMORY_SCOPE_AGENT); }
__device__ __forceinline__ unsigned xb_xcc_id() { return (unsigned)__builtin_amdgcn_s_getreg((3 << 11) | 20) & 0xFu; }
#define XB_SPIN(cond, bar) do { unsigned _sp = 0; while (cond) { __builtin_amdgcn_s_sleep(1); \
    if ((++_sp & 255u) == 0u) { if (xb_ld(&(bar)[XB_TMO])) break; if (_sp > XB_SPIN_CAP) { atomicAdd(&(bar)[XB_TMO], 1u); break; } } } } while (0)

struct XcdBarrier {
    unsigned* bar; unsigned x;
    volatile LAS unsigned* st;
};

__device__ __forceinline__ XcdBarrier xcd_barrier_post(unsigned* bar, volatile LAS unsigned* st) {
    XcdBarrier b; b.bar = bar; b.x = xb_xcc_id(); b.st = st;
    if (threadIdx.x == 0) (void)xb_add(&bar[XB_XCNT(b.x)], 1u);
    return b;
}
__device__ __forceinline__ void xcd_barrier_complete(unsigned* bar, unsigned x, unsigned& nloc, unsigned& nx) {
    const unsigned G = gridDim.x * gridDim.y * gridDim.z;
    unsigned sum, cnt, mine, sp = 0u;
    for (;;) {
        sum = 0u; cnt = 0u; mine = 0u;
#pragma unroll
        for (unsigned j = 0; j < 16; ++j) { const unsigned c = xb_ld(&bar[XB_XCNT(j)]); sum += c; cnt += (c > 0u) ? 1u : 0u; mine = (j == x) ? c : mine; }
        if (sum == G) break;
        __builtin_amdgcn_s_sleep(1);
        if ((++sp & 255u) == 0u) { if (xb_ld(&bar[XB_TMO])) break; if (sp > XB_SPIN_CAP) { atomicAdd(&bar[XB_TMO], 1u); break; } }
    }
    nloc = mine > 0u ? mine : 1u; nx = cnt > 0u ? cnt : 1u;
}

__device__ __forceinline__ void xcd_barrier(const XcdBarrier& b) {
    asm volatile("s_waitcnt vmcnt(0)" ::: "memory");
    __syncthreads();
    if (threadIdx.x == 0) {
        unsigned* bar = b.bar;
        __builtin_amdgcn_s_waitcnt(0);
        unsigned nloc = b.st[0], nx = b.st[1];
        if (nloc == 0u) { xcd_barrier_complete(bar, b.x, nloc, nx); b.st[0] = nloc; b.st[1] = nx; }
        const unsigned old = xb_add(&bar[XB_XSUB(b.x)], 1u);
        const unsigned gen = old / nloc;
        if (old + 1u == (gen + 1u) * nloc) {
            __builtin_amdgcn_fence(__ATOMIC_RELEASE, "agent");
            asm volatile("s_waitcnt vmcnt(0)" ::: "memory");
            const unsigned og = xb_add(&bar[XB_TOP], 1u);
            const unsigned tg = og / nx;
            if (og + 1u == (tg + 1u) * nx) xb_add(&bar[XB_TOPGEN], 1u);
            else XB_SPIN(xb_ld(&bar[XB_TOPGEN]) == tg, bar);
            __builtin_amdgcn_fence(__ATOMIC_ACQUIRE, "agent");
            xb_add(&bar[XB_XGEN(b.x)], 1u);
            asm volatile("s_waitcnt vmcnt(0)" ::: "memory");
        } else {
            XB_SPIN(xb_ld(&bar[XB_XGEN(b.x)]) == gen, bar);
            __builtin_amdgcn_fence(__ATOMIC_ACQUIRE, "agent");
            asm volatile("s_waitcnt vmcnt(0)" ::: "memory");
        }
    }
    __syncthreads();
}


constexpr int NPHASES = 1 + 4 * 9;

template <int SP>
DI void run_sub(const Params& P, int l, char* smem) {
  const bool last = l == 3;
  const int rows_act = last ? NLAT : NROW;
  if constexpr (SP == 9) { ph_prologue(P, smem); }
  else if constexpr (SP == 0) { ph_norm(P, l, 0, NROW); }
  else if constexpr (SP == 1) { ph_gemm<0>(P, l, (const bf16_t*)(P.ws + OFF_H), (const bf16_t*)(P.ws + OFF_WIN) + l * W_IN_E, NROW, INW, DM, 0, false, smem); }
  else if constexpr (SP == 2) {
    const int nattn = last ? 512 : 576;
    const int total = nattn + 576;
    for (int it = blockIdx.x; it < total; it += gridDim.x) {
      if (it < nattn) attn_item(P, l, it, smem);
      else ssm1_item(P, l, it - nattn);
      __syncthreads();
    }
  }
  else if constexpr (SP == 3) {
    const int npool = rows_act / 32;
    for (int it = blockIdx.x; it < 576 + npool; it += gridDim.x) {
      if (it < 576) ssm3_item(P, l, it, smem);
      else pool_item(P, l, it - 576, smem);
      __syncthreads();
    }
  }
  else if constexpr (SP == 4) { for (int it = blockIdx.x; it < rows_act / 64; it += gridDim.x) { glu_item(P, l, it, smem); __syncthreads(); } }
  else if constexpr (SP == 5) { ph_gemm<1>(P, l, (const bf16_t*)(P.ws + OFF_CAT), (const bf16_t*)(P.ws + OFF_WOUT) + l * W_OUT_E, rows_act, DM, DM, 2, false, smem); }
  else if constexpr (SP == 6) { ph_norm(P, l, 1, rows_act); }
  else if constexpr (SP == 7) { ph_gemm<2>(P, l, (const bf16_t*)(P.ws + OFF_H), (const bf16_t*)(P.ws + OFF_WGU) + l * W_GU_E, rows_act, 2 * DFF, DM, 0, false, smem); }
  else if constexpr (SP == 8) { ph_gemm<1>(P, l, (const bf16_t*)(P.ws + OFF_ACT), (const bf16_t*)(P.ws + OFF_WD) + l * W_D_E, rows_act, DM, DFF, 5, last, smem); }
}

DI void run_phase(const Params& P, int ph, char* smem) {
  if (ph == 0) { run_sub<9>(P, 0, smem); return; }
  const int l = (ph - 1) / 9, sp = (ph - 1) % 9;
  switch (sp) {
    case 0: run_sub<0>(P, l, smem); break;
    case 1: run_sub<1>(P, l, smem); break;
    case 2: run_sub<2>(P, l, smem); break;
    case 3: run_sub<3>(P, l, smem); break;
    case 4: run_sub<4>(P, l, smem); break;
    case 5: run_sub<5>(P, l, smem); break;
    case 6: run_sub<6>(P, l, smem); break;
    case 7: run_sub<7>(P, l, smem); break;
    case 8: run_sub<8>(P, l, smem); break;
  }
}

extern __shared__ __attribute__((aligned(16))) char dyn_smem[];

#if !MEGA
template <int SP> __global__ void __launch_bounds__(NTHREADS, 2) k_sub(Params P, int l) { run_sub<SP>(P, l, dyn_smem); }
#endif

#if MEGA
__global__ void __launch_bounds__(NTHREADS, 2) k_mega(Params P) {
  cg::grid_group grid = cg::this_grid();
  uint4* xbw = (uint4*)(dyn_smem + LDS_PHASE);
  if (threadIdx.x == 0) *xbw = make_uint4(0u, 0u, 0u, 0u);
  __syncthreads();
  XcdBarrier xb = xcd_barrier_post((unsigned*)(P.ws + OFF_BAR), (volatile LAS unsigned*)xbw);
  run_sub<9>(P, 0, dyn_smem);
  if (P.ws == nullptr) grid.sync();
  xcd_barrier(xb);
#pragma unroll 1
  for (int l = 0; l < 4; ++l) {
    run_sub<0>(P, l, dyn_smem); xcd_barrier(xb);
    run_sub<1>(P, l, dyn_smem); xcd_barrier(xb);
    run_sub<2>(P, l, dyn_smem); xcd_barrier(xb);
    run_sub<3>(P, l, dyn_smem); xcd_barrier(xb);
    run_sub<4>(P, l, dyn_smem); xcd_barrier(xb);
    run_sub<5>(P, l, dyn_smem); xcd_barrier(xb);
    run_sub<6>(P, l, dyn_smem); xcd_barrier(xb);
    run_sub<7>(P, l, dyn_smem); xcd_barrier(xb);
    run_sub<8>(P, l, dyn_smem);
    if (l < 3) xcd_barrier(xb);
  }
}
#define OCC_KERNEL k_mega
#else
#define OCC_KERNEL k_sub<1>
#endif

extern "C" void kernel_launch(void* const* d_in, const int* in_sizes, int n_in, void* d_out, int out_size, void* d_ws, size_t ws_size,
                              hipStream_t stream) {
  if (n_in < 28 || ws_size < WS_END) { fprintf(stderr, "kernel_launch: bad inputs (n_in %d, ws %zu < %zu)\n", n_in, ws_size, (size_t)WS_END); return; }
  Params P{};
  const float** pp = (const float**)&P;
  for (int i = 0; i < 28; ++i) pp[i] = (const float*)d_in[i];
  P.out = (float*)d_out;
  P.ws = (char*)d_ws;
  static int grid_blocks = 0;
  if (!grid_blocks) {
    int dev = 0, cus = 0, per_cu = 0;
    hipGetDevice(&dev);
    hipDeviceGetAttribute(&cus, hipDeviceAttributeMultiprocessorCount, dev);
#if MEGA
    hipFuncSetAttribute((const void*)k_mega, hipFuncAttributeMaxDynamicSharedMemorySize, LDS_BYTES);
#endif
#if !MEGA
    hipFuncSetAttribute((const void*)k_sub<0>, hipFuncAttributeMaxDynamicSharedMemorySize, LDS_BYTES);
    hipFuncSetAttribute((const void*)k_sub<1>, hipFuncAttributeMaxDynamicSharedMemorySize, LDS_BYTES);
    hipFuncSetAttribute((const void*)k_sub<2>, hipFuncAttributeMaxDynamicSharedMemorySize, LDS_BYTES);
    hipFuncSetAttribute((const void*)k_sub<3>, hipFuncAttributeMaxDynamicSharedMemorySize, LDS_BYTES);
    hipFuncSetAttribute((const void*)k_sub<4>, hipFuncAttributeMaxDynamicSharedMemorySize, LDS_BYTES);
    hipFuncSetAttribute((const void*)k_sub<5>, hipFuncAttributeMaxDynamicSharedMemorySize, LDS_BYTES);
    hipFuncSetAttribute((const void*)k_sub<6>, hipFuncAttributeMaxDynamicSharedMemorySize, LDS_BYTES);
    hipFuncSetAttribute((const void*)k_sub<7>, hipFuncAttributeMaxDynamicSharedMemorySize, LDS_BYTES);
    hipFuncSetAttribute((const void*)k_sub<8>, hipFuncAttributeMaxDynamicSharedMemorySize, LDS_BYTES);
    hipFuncSetAttribute((const void*)k_sub<9>, hipFuncAttributeMaxDynamicSharedMemorySize, LDS_BYTES);
#endif
    hipOccupancyMaxActiveBlocksPerMultiprocessor(&per_cu, (const void*)OCC_KERNEL, NTHREADS, LDS_BYTES);
    if (per_cu < 1) per_cu = 1;
    if (per_cu > 2) per_cu = 2;
    grid_blocks = cus * per_cu;
  }
#if MEGA
  hipMemsetAsync((char*)d_ws + OFF_BAR, 0, BAR_BYTES, stream);
  void* args[] = {&P};
  hipError_t e = hipLaunchCooperativeKernel((const void*)k_mega, dim3(grid_blocks), dim3(NTHREADS), args, LDS_BYTES, stream);
  if (e != hipSuccess) fprintf(stderr, "cooperative launch failed: %s (grid %d)\n", hipGetErrorString(e), grid_blocks);
#else
  const dim3 G(grid_blocks), T(NTHREADS);
  k_sub<9><<<G, T, LDS_BYTES, stream>>>(P, 0);
  for (int l = 0; l < 4; ++l) {
    k_sub<0><<<G, T, LDS_BYTES, stream>>>(P, l);
    k_sub<1><<<G, T, LDS_BYTES, stream>>>(P, l);
    k_sub<2><<<G, T, LDS_BYTES, stream>>>(P, l);
    k_sub<3><<<G, T, LDS_BYTES, stream>>>(P, l);
    k_sub<4><<<G, T, LDS_BYTES, stream>>>(P, l);
    k_sub<5><<<G, T, LDS_BYTES, stream>>>(P, l);
    k_sub<6><<<G, T, LDS_BYTES, stream>>>(P, l);
    k_sub<7><<<G, T, LDS_BYTES, stream>>>(P, l);
    k_sub<8><<<G, T, LDS_BYTES, stream>>>(P, l);
  }
#endif
}
```

```cpp
#include <hip/hip_runtime.h>
#include <hip/hip_cooperative_groups.h>
#include <stdint.h>
#include <stdio.h>
namespace cg = cooperative_groups;

#ifndef MEGA
#define MEGA 1
#endif

typedef unsigned short bf16_t;
using bf16x8 = __attribute__((ext_vector_type(8))) short;
using f32x4 = __attribute__((ext_vector_type(4))) float;
using f32x16 = __attribute__((ext_vector_type(16))) float;
#define DI __device__ __forceinline__
#define MFMA16(a, b, c) __builtin_amdgcn_mfma_f32_16x16x32_bf16((a), (b), (c), 0, 0, 0)
#define MFMA32(a, b, c) __builtin_amdgcn_mfma_f32_32x32x16_bf16((a), (b), (c), 0, 0, 0)

constexpr int NLAT = 16384, NROW = 18432, DM = 1024, INW = 1280, DFF = 2816;
constexpr int LDS_PHASE = 65536;
constexpr int LDS_BYTES = LDS_PHASE + 16;
constexpr int NTHREADS = 256;

constexpr size_t OFF_XRES = 0;
constexpr size_t OFF_H = OFF_XRES + (size_t)NROW * DM * 4;
constexpr size_t OFF_UNI = OFF_H + (size_t)NROW * DM * 2;
constexpr size_t OFF_PROJ = OFF_UNI;
constexpr size_t OFF_CAT = OFF_PROJ + (size_t)NROW * INW * 2;
constexpr size_t OFF_YSSM = OFF_CAT + (size_t)NROW * DM * 2;
constexpr size_t OFF_VT = OFF_YSSM;
constexpr size_t OFF_ACT = OFF_UNI;
constexpr size_t OFF_W = OFF_YSSM + (size_t)2 * NROW * 256 * 4;
constexpr size_t W_IN_E = (size_t)INW * DM, W_OUT_E = (size_t)DM * DM, W_GU_E = (size_t)2 * DFF * DM, W_D_E = (size_t)DM * DFF, W_GLU_E = 65536;
constexpr size_t OFF_WIN = OFF_W;
constexpr size_t OFF_WOUT = OFF_WIN + 4 * W_IN_E * 2;
constexpr size_t OFF_WGU = OFF_WOUT + 4 * W_OUT_E * 2;
constexpr size_t OFF_WD = OFF_WGU + 4 * W_GU_E * 2;
constexpr size_t OFF_GLUT = OFF_WD + 4 * W_D_E * 2;
constexpr size_t OFF_MOD = OFF_GLUT + 4 * W_GLU_E * 2;
constexpr size_t OFF_KTAB = OFF_MOD + (size_t)4 * 9 * 6144 * 4;
constexpr size_t OFF_ETAB = OFF_KTAB + (size_t)128 * 16384 * 2;
constexpr size_t OFF_FTAB = OFF_ETAB + (size_t)128 * 131072 * 2;
constexpr size_t OFF_AT = OFF_FTAB + (size_t)128 * 131072 * 2;
constexpr size_t OFF_ROPE = OFF_AT + (size_t)128 * 64 * 8;
constexpr size_t OFF_BAR = OFF_ROPE + 64 * 16 * 8;
constexpr size_t BAR_BYTES = 3456 * 4;
constexpr size_t OFF_POOLT = OFF_BAR + BAR_BYTES;
constexpr size_t WS_END = OFF_POOLT + (size_t)4 * 4 * 64 * 64 * 2;
constexpr size_t OFF_SLOC = OFF_H;

struct Params {
  const float *x, *c, *ctx, *c_ctx, *w_mod, *b_mod, *norm_mix, *norm_ffn, *w_in, *w_out, *pool_w, *pool_scale;
  const float *a_re, *a_im, *log_dt, *b_re, *b_im, *c_re, *c_im, *ssm_d, *glu_w, *glu_b, *q_norm, *k_norm, *sink;
  const float *w_gate, *w_up, *w_down;
  float* out;
  char* ws;
};

DI unsigned short f2bf(float x) { unsigned u = __float_as_uint(x); u += 0x7fffu + ((u >> 16) & 1u); return (unsigned short)(u >> 16); }
DI float bf2f(unsigned short h) { return __uint_as_float(((unsigned)h) << 16); }
DI unsigned pack2(float a, float b) { unsigned r; asm("v_cvt_pk_bf16_f32 %0, %1, %2\n\ts_nop 1" : "=v"(r) : "v"(a), "v"(b)); return r; }
DI float bflo(unsigned u) { return __uint_as_float(u << 16); }
DI float bfhi(unsigned u) { return __uint_as_float(u & 0xffff0000u); }
DI int otid() { int t = threadIdx.x; asm volatile("" : "+v"(t)); return t; }
DI float frcp(float x) { return __builtin_amdgcn_rcpf(x); }
DI int crow32(int i, int h) { return (i & 3) + 8 * (i >> 2) + 4 * h; }

DI void sincos_d(double x, double* sn, double* cs) {
  const double kd = rint(x * 0.6366197723675814);
  double r = fma(-kd, 1.5707963267948966, x);
  r = fma(-kd, 6.123233995736766e-17, r);
  const int k = ((int)kd) & 3;
  const double r2 = r * r;
  const double sp = r + r * r2 * (-1.0 / 6 + r2 * (1.0 / 120 + r2 * (-1.0 / 5040 + r2 * (1.0 / 362880 + r2 * (-1.0 / 39916800 + r2 * (1.0 / 6227020800.0 + r2 * (-1.0 / 1307674368000.0)))))));
  const double cp = 1.0 + r2 * (-0.5 + r2 * (1.0 / 24 + r2 * (-1.0 / 720 + r2 * (1.0 / 40320 + r2 * (-1.0 / 3628800 + r2 * (1.0 / 479001600 + r2 * (-1.0 / 87178291200.0)))))));
  const double s0 = (k & 1) ? cp : sp, c0 = (k & 1) ? sp : cp;
  *sn = (k & 2) ? -s0 : s0;
  *cs = ((k + 1) & 2) ? -c0 : c0;
}
DI void pro_ssm(const Params& P, int item, char* smem) {
  const int tid = otid();
  const int tb = item >> 2, qt = item & 3;
  const int l = tb >> 5, g = (tb >> 1) & 15, dir = tb & 1;
  const int ig = (l * 2 + dir) * 16 + g;
  float2* apow = (float2*)smem;
  float2* bbar = apow + 65 * 64;
  float2* cm = bbar + 64 * 16;
  const double dt = exp((double)P.log_dt[ig]);
  {
    const int p = tid & 63;
    const double lre = fmin((double)P.a_re[ig * 64 + p], -1e-4), lim = (double)P.a_im[ig * 64 + p];
#pragma unroll 1
    for (int e = tid >> 6; e <= 64; e += 4) {
      double mag = exp(lre * dt * (double)e), sn, cs;
      sincos_d(lim * dt * (double)e, &sn, &cs);
      apow[e * 64 + p] = make_float2((float)(mag * cs), (float)(mag * sn));
    }
  }
#pragma unroll 1
  for (int i = 0; i < 4; ++i) {
    const int idx = tid + 256 * i, p = idx >> 4, c = idx & 15;
    const double lre = fmin((double)P.a_re[ig * 64 + p], -1e-4), lim = (double)P.a_im[ig * 64 + p];
    double mag = exp(lre * dt), sn, cs;
    sincos_d(lim * dt, &sn, &cs);
    const double nre = mag * cs - 1.0, nim = mag * sn;
    const double den = lre * lre + lim * lim;
    const double cre = (nre * lre + nim * lim) / den, cim = (nim * lre - nre * lim) / den;
    const double bre = (double)P.b_re[(size_t)(ig * 64 + p) * 16 + c], bim = (double)P.b_im[(size_t)(ig * 64 + p) * 16 + c];
    bbar[p * 16 + c] = make_float2((float)(cre * bre - cim * bim), (float)(cre * bim + cim * bre));
    const int c2 = idx >> 6, p2 = idx & 63;
    cm[c2 * 64 + p2] = make_float2(P.c_re[(size_t)(ig * 16 + c2) * 64 + p2], P.c_im[(size_t)(ig * 16 + c2) * 64 + p2]);
  }
  __syncthreads();
  bf16_t* KT = (bf16_t*)(P.ws + OFF_KTAB) + (size_t)tb * 16384;
  bf16_t* ET = (bf16_t*)(P.ws + OFF_ETAB) + (size_t)tb * 131072;
  bf16_t* FT = (bf16_t*)(P.ws + OFF_FTAB) + (size_t)tb * 131072;
  {
    const int ci = tid & 15, co = tid >> 4;
#pragma unroll 1
    for (int tt = 0; tt < 16; ++tt) {
      const int tau = qt * 16 + tt;
      float acc = 0.f;
#pragma unroll 4
      for (int p = 0; p < 64; ++p) {
        const float2 cc = cm[co * 64 + p], aa = apow[tau * 64 + p], bb = bbar[p * 16 + ci];
        const float xr = cc.x * aa.x - cc.y * aa.y, xi = cc.x * aa.y + cc.y * aa.x;
        acc += xr * bb.x - xi * bb.y;
      }
      KT[tau * 256 + co * 16 + ci] = f2bf(acc);
    }
  }
  {
    const int c = tid & 15, ol = tid >> 4, off = qt * 16 + ol;
    const int e = dir == 0 ? 63 - off : off;
#pragma unroll 2
    for (int p = 0; p < 64; ++p) {
      const float2 aa = apow[e * 64 + p], bb = bbar[p * 16 + c];
      ET[(size_t)p * 1024 + off * 16 + c] = f2bf(aa.x * bb.x - aa.y * bb.y);
      ET[(size_t)(64 + p) * 1024 + off * 16 + c] = f2bf(aa.x * bb.y + aa.y * bb.x);
    }
  }
  {
    const int col = tid & 127, half = tid >> 7, p = col & 63, part = col >> 6;
#pragma unroll 2
    for (int rr = 0; rr < 128; ++rr) {
      const int rowl = half * 128 + rr, off = qt * 16 + (rowl >> 4), co = rowl & 15;
      const int e = dir == 0 ? off + 1 : 64 - off;
      const float2 cc = cm[co * 64 + p], aa = apow[e * 64 + p];
      const float vr = cc.x * aa.x - cc.y * aa.y, vi = cc.x * aa.y + cc.y * aa.x;
      FT[(size_t)(off * 16 + co) * 128 + col] = f2bf(part == 0 ? vr : -vi);
    }
  }
  if (qt == 0 && tid < 64) ((float2*)(P.ws + OFF_AT))[tb * 64 + tid] = apow[64 * 64 + tid];
}

DI void pro_mod(const Params& P, int item, char* smem) {
  const int tid = otid();
  const int l = item / 96, n0 = (item % 96) * 64;
  float* sl = (float*)smem;
  float* red = sl;
  for (int i = tid; i < 9 * 1024; i += 256) {
    const int r = i >> 10, k = i & 1023;
    const float v = r < 8 ? P.c[r * 1024 + k] : P.c_ctx[k];
    sl[i] = v / (1.f + __expf(-v));
  }
  __syncthreads();
  const int kq = tid >> 4, cq = tid & 15;
  float acc[9][4];
#pragma unroll
  for (int r = 0; r < 9; ++r) { acc[r][0] = acc[r][1] = acc[r][2] = acc[r][3] = 0.f; }
  const float* wp = P.w_mod + (size_t)l * 1024 * 6144 + n0 + cq * 4;
#pragma unroll 4
  for (int i = 0; i < 64; ++i) {
    const int k = kq + 16 * i;
    const float4 w = *(const float4*)(wp + (size_t)k * 6144);
#pragma unroll
    for (int r = 0; r < 9; ++r) {
      const float s = sl[r * 1024 + k];
      acc[r][0] += s * w.x; acc[r][1] += s * w.y; acc[r][2] += s * w.z; acc[r][3] += s * w.w;
    }
  }
  __syncthreads();
#pragma unroll
  for (int r = 0; r < 9; ++r)
#pragma unroll
    for (int j = 0; j < 4; ++j) red[(kq * 9 + r) * 64 + cq * 4 + j] = acc[r][j];
  __syncthreads();
  float* MOD = (float*)(P.ws + OFF_MOD);
  for (int o = tid; o < 9 * 64; o += 256) {
    const int r = o >> 6, cc = o & 63;
    float s = P.b_mod[l * 6144 + n0 + cc];
    for (int q = 0; q < 16; ++q) s += red[(q * 9 + r) * 64 + cc];
    MOD[(size_t)(l * 9 + r) * 6144 + n0 + cc] = s;
  }
}

DI void pro_poolw(const Params& P, int item) {
  const int tid = otid();
  bf16_t* PT = (bf16_t*)(P.ws + OFF_POOLT);
  float v[16];
#pragma unroll
  for (int i = 0; i < 16; ++i) {
    const int e = item * 4096 + i * 256 + tid, lg = e >> 12, o = (e >> 6) & 63, c = e & 63;
    v[i] = P.pool_w[(size_t)lg * 4096 + c * 64 + o];
  }
#pragma unroll
  for (int i = 0; i < 16; ++i) PT[item * 4096 + i * 256 + tid] = f2bf(v[i]);
}

DI void pro_rope(const Params& P) {
  float2* R = (float2*)(P.ws + OFF_ROPE);
  for (int i = otid(); i < 1024; i += 256) {
    const int v = i >> 4, f = i & 15;
    const double inv = exp(-(double)f * (9.210340371976184 / 16.0));
    double sn, cs;
    sincos_d((double)v * inv, &sn, &cs);
    R[i] = make_float2((float)cs, (float)sn);
  }
}

DI void pro_transpose(const Params& P, int idx, char* smem) {
  const int tid = otid();
  const int l = idx / 2704;
  int r = idx % 2704;
  const float* src; bf16_t* dst; int K, N, kt, nt, rs = 16, ro = 0;
  if (r < 320) { src = P.w_in + (size_t)l * 1024 * 1280; dst = (bf16_t*)(P.ws + OFF_WIN) + l * W_IN_E; K = 1024; N = 1280; kt = r / 20; nt = r % 20; }
  else if (r < 576) { r -= 320; src = P.w_out + (size_t)l * 1024 * 1024; dst = (bf16_t*)(P.ws + OFF_WOUT) + l * W_OUT_E; K = 1024; N = 1024; kt = r / 16; nt = r % 16; }
  else if (r < 1280) { r -= 576; src = P.w_gate + (size_t)l * 1024 * 2816; dst = (bf16_t*)(P.ws + OFF_WGU) + l * W_GU_E; K = 1024; N = 2816; kt = r / 44; nt = r % 44; rs = 32; }
  else if (r < 1984) { r -= 1280; src = P.w_up + (size_t)l * 1024 * 2816; dst = (bf16_t*)(P.ws + OFF_WGU) + l * W_GU_E; K = 1024; N = 2816; kt = r / 44; nt = r % 44; rs = 32; ro = 16; }
  else if (r < 2688) { r -= 1984; src = P.w_down + (size_t)l * 2816 * 1024; dst = (bf16_t*)(P.ws + OFF_WD) + l * W_D_E; K = 2816; N = 1024; kt = r / 16; nt = r % 16; }
  else { r -= 2688; src = P.glu_w + (size_t)l * 65536; dst = (bf16_t*)(P.ws + OFF_GLUT) + l * W_GLU_E; K = 256; N = 256; kt = r / 4; nt = r % 4; }
  float* tile = (float*)smem;
  const int k0 = kt * 64, n0 = nt * 64;
  {
    const int kr = tid >> 4, nc = (tid & 15) * 4;
#pragma unroll
    for (int i = 0; i < 4; ++i) {
      const float4 v = *(const float4*)(src + (size_t)(k0 + kr + 16 * i) * N + n0 + nc);
      tile[(nc + 0) * 65 + kr + 16 * i] = v.x; tile[(nc + 1) * 65 + kr + 16 * i] = v.y;
      tile[(nc + 2) * 65 + kr + 16 * i] = v.z; tile[(nc + 3) * 65 + kr + 16 * i] = v.w;
    }
  }
  __syncthreads();
  {
    const int n = tid >> 2, kq = (tid & 3) * 16;
    const int ng = n0 + n;
    const int drow = (ng >> 4) * rs + (ng & 15) + ro;
    unsigned o[8];
#pragma unroll
    for (int j = 0; j < 8; ++j) o[j] = pack2(tile[n * 65 + kq + 2 * j], tile[n * 65 + kq + 2 * j + 1]);
    uint4* d = (uint4*)(dst + (size_t)drow * K + k0 + kq);
    d[0] = make_uint4(o[0], o[1], o[2], o[3]);
    d[1] = make_uint4(o[4], o[5], o[6], o[7]);
  }
}

DI void pro_copy(const Params& P, int item) {
  const int tid = otid();
  const size_t base = (size_t)item * 4096;
  float4* dst = (float4*)(P.ws + OFF_XRES);
#pragma unroll
  for (int i = 0; i < 4; ++i) {
    const size_t e = base + (size_t)(tid + 256 * i) * 4;
    const float4 v = e < (size_t)NLAT * DM ? *(const float4*)(P.x + e) : *(const float4*)(P.ctx + (e - (size_t)NLAT * DM));
    dst[e >> 2] = v;
  }
}

constexpr int PRO_SSM = 512, PRO_MOD = 384, PRO_TR = 10816, PRO_PW = 16;
constexpr int PRO_ITEMS = PRO_SSM + PRO_MOD + 1 + PRO_PW + PRO_TR;

DI void ph_prologue(const Params& P, char* smem) {
  for (int item = blockIdx.x; item < PRO_ITEMS; item += gridDim.x) {
    if (item < PRO_SSM) pro_ssm(P, item, smem);
    else if (item < PRO_SSM + PRO_MOD) pro_mod(P, item - PRO_SSM, smem);
    else if (item < PRO_SSM + PRO_MOD + 1) pro_rope(P);
    else if (item < PRO_SSM + PRO_MOD + 1 + PRO_PW) pro_poolw(P, item - (PRO_SSM + PRO_MOD + 1));
    else pro_transpose(P, item - (PRO_SSM + PRO_MOD + 1 + PRO_PW), smem);
    __syncthreads();
  }
}

DI void ph_norm(const Params& P, int l, int which, int nrows) {
  const bool seed = (l == 0 && which == 0);
  const int tid = otid(), lane = tid & 63, w = tid >> 6;
  float* XR = (float*)(P.ws + OFF_XRES);
  bf16_t* H = (bf16_t*)(P.ws + OFF_H);
  const float* MOD = (const float*)(P.ws + OFF_MOD);
  const float* g = (which ? P.norm_ffn : P.norm_mix) + l * 1024;
  for (int row = blockIdx.x * 4 + w; row < nrows; row += gridDim.x * 4) {
    const float4* xr = seed ? (const float4*)(row < NLAT ? P.x + (size_t)row * 1024 : P.ctx + (size_t)(row - NLAT) * 1024) : (const float4*)(XR + (size_t)row * 1024);
    float4 v[4];
    float ss = 0.f;
#pragma unroll
    for (int i = 0; i < 4; ++i) { v[i] = xr[lane + 64 * i]; ss += v[i].x * v[i].x + v[i].y * v[i].y + v[i].z * v[i].z + v[i].w * v[i].w; }
#pragma unroll
    for (int m = 32; m >= 1; m >>= 1) ss += __shfl_xor(ss, m);
    const float rstd = rsqrtf(ss * (1.f / 1024.f) + 1e-6f);
    if (seed) {
#pragma unroll
      for (int i = 0; i < 4; ++i) ((float4*)(XR + (size_t)row * 1024))[lane + 64 * i] = v[i];
    }
    const int mr = row < NLAT ? (row >> 11) : 8;
    const float* mp = MOD + (size_t)(l * 9 + mr) * 6144;
    const float* sh = mp + (which ? 3 : 0) * 1024;
    const float* sc = mp + (which ? 4 : 1) * 1024;
#pragma unroll
    for (int i = 0; i < 4; ++i) {
      const int col = (lane + 64 * i) * 4;
      const float4 gg = *(const float4*)(g + col), s1 = *(const float4*)(sc + col), s0 = *(const float4*)(sh + col);
      const float h0 = v[i].x * rstd * gg.x * (1.f + s1.x) + s0.x;
      const float h1 = v[i].y * rstd * gg.y * (1.f + s1.y) + s0.y;
      const float h2 = v[i].z * rstd * gg.z * (1.f + s1.z) + s0.z;
      const float h3 = v[i].w * rstd * gg.w * (1.f + s1.w) + s0.w;
      *(uint2*)(H + (size_t)row * 1024 + col) = make_uint2(pack2(h0, h1), pack2(h2, h3));
    }
  }
}

#define LDSAS __attribute__((address_space(3)))
DI void glds_tile(const bf16_t* gA, const bf16_t* gB, int K, int kt, bf16_t* sA, bf16_t* sB, int buf, int w, int lane) {
  const int c = (lane & 7) ^ (lane >> 3);
#pragma unroll
  for (int j = 0; j < 4; ++j) {
    const int rb = 4 * w + j, row = 8 * rb + (lane >> 3);
    const bf16_t* srcA = gA + (size_t)row * K + kt * 64 + c * 8;
    const bf16_t* srcB = gB + (size_t)row * K + kt * 64 + c * 8;
    bf16_t* dA = sA + buf * 128 * 64 + rb * 512 + lane * 8;
    bf16_t* dB = sB + buf * 128 * 64 + rb * 512 + lane * 8;
    __builtin_amdgcn_global_load_lds((const void*)srcA, (LDSAS void*)dA, 16, 0, 0);
    __builtin_amdgcn_global_load_lds((const void*)srcB, (LDSAS void*)dB, 16, 0, 0);
  }
}

template <int EPI>
DI void ph_gemm(const Params& P, int l, const bf16_t* __restrict__ A, const bf16_t* __restrict__ Bt, int M, int N, int K,
                int gidx, bool final_out, char* smem) {
  const int tid = otid(), lane = tid & 63, w = tid >> 6, wr = w >> 1, wc = w & 1, fr = lane & 15, fq = lane >> 4;
  bf16_t* sA = (bf16_t*)smem;
  bf16_t* sB = sA + 2 * 128 * 64;
  const int tm = M >> 7, tn = N >> 7, ntiles = tm * tn, nk = K >> 6;
  const int lrow = tid >> 3, lk = (tid & 7) * 8;
  const int lsw = ((tid & 7) ^ (lrow & 7)) * 8;
  auto tile_of = [&](int s_, int& m0_, int& n0_) {
    const int t = (s_ & 7) * (ntiles >> 3) + (s_ >> 3);
    const int grp = t / (8 * tn), rem = t % (8 * tn);
    m0_ = (grp * 8 + (rem & 7)) << 7; n0_ = (rem >> 3) << 7;
  };
  if ((int)blockIdx.x < ntiles) {
    int m0, n0; tile_of(blockIdx.x, m0, n0);
    glds_tile(A + (size_t)m0 * K, Bt + (size_t)n0 * K, K, 0, sA, sB, 0, w, lane);
  }
  for (int s = blockIdx.x; s < ntiles; s += gridDim.x) {
    int m0, n0; tile_of(s, m0, n0);
    const bool has_next = s + (int)gridDim.x < ntiles;
    int m0n = 0, n0n = 0;
    if (has_next) tile_of(s + gridDim.x, m0n, n0n);
    f32x4 acc[4][4];
#pragma unroll
    for (int m = 0; m < 4; ++m)
#pragma unroll
      for (int n = 0; n < 4; ++n) acc[m][n] = f32x4{0.f, 0.f, 0.f, 0.f};
    const bf16_t* gA = A + (size_t)m0 * K;
    const bf16_t* gB = Bt + (size_t)n0 * K;
    asm volatile("s_waitcnt vmcnt(0)" ::: "memory");
    __syncthreads();
    for (int kt = 0; kt < nk; ++kt) {
      const int cur = kt & 1;
      if (kt + 1 < nk) glds_tile(gA, gB, K, kt + 1, sA, sB, cur ^ 1, w, lane);
      else if (has_next) glds_tile(A + (size_t)m0n * K, Bt + (size_t)n0n * K, K, 0, sA, sB, 0, w, lane);
      const bf16_t* cA = sA + cur * 128 * 64 + (wr * 64 + fr) * 64;
      const bf16_t* cB = sB + cur * 128 * 64 + (wc * 64 + fr) * 64;
#pragma unroll
      for (int ks = 0; ks < 2; ++ks) {
        bf16x8 af[4], bfr[4];
#pragma unroll
        for (int m = 0; m < 4; ++m) af[m] = *(const bf16x8*)(cA + m * 16 * 64 + (((ks * 4 + fq) ^ (fr & 7)) * 8));
#pragma unroll
        for (int n = 0; n < 4; ++n) bfr[n] = *(const bf16x8*)(cB + n * 16 * 64 + (((ks * 4 + fq) ^ (fr & 7)) * 8));
        __builtin_amdgcn_s_setprio(1);
#pragma unroll
        for (int m = 0; m < 4; ++m)
#pragma unroll
          for (int n = 0; n < 4; ++n) acc[m][n] = MFMA16(bfr[n], af[m], acc[m][n]);
        __builtin_amdgcn_s_setprio(0);
      }
      if (kt + 1 < nk) {
        asm volatile("s_waitcnt vmcnt(0)" ::: "memory");
        __syncthreads();
      }
    }
    if (EPI == 0) {
      bf16_t* C = (bf16_t*)(P.ws + OFF_PROJ);
      const int col0 = n0 + wc * 64;
      if (col0 >= 512 && col0 < 1152) {
        const bool isq = col0 < 1024;
        const float* nw = (isq ? P.q_norm : P.k_norm) + l * 64 + fq * 4;
        const float2* ROPE = (const float2*)(P.ws + OFF_ROPE);
        float nwv[4][4];
#pragma unroll
        for (int n = 0; n < 4; ++n)
#pragma unroll
          for (int j = 0; j < 4; ++j) nwv[n][j] = nw[n * 16 + j];
#pragma unroll
        for (int m = 0; m < 4; ++m) {
          float ss = 0.f;
#pragma unroll
          for (int n = 0; n < 4; ++n)
#pragma unroll
            for (int j = 0; j < 4; ++j) ss += acc[m][n][j] * acc[m][n][j];
          ss += __shfl_xor(ss, 16);
          ss += __shfl_xor(ss, 32);
          const float rs = rsqrtf(ss * (1.f / 64.f) + 1e-6f) * (isq ? 0.125f * 1.4426950408889634f : 1.f);
#pragma unroll
          for (int n = 0; n < 4; ++n)
#pragma unroll
            for (int j = 0; j < 4; ++j) acc[m][n][j] *= rs * nwv[n][j];
          const int row = m0 + wr * 64 + m * 16 + fr;
          if (row < NLAT) {
            const int t = row & 2047;
#pragma unroll
            for (int a = 0; a < 2; ++a) {
              const int v = a == 0 ? (t >> 6) : (t & 63);
#pragma unroll
              for (int j = 0; j < 4; ++j) {
                const float2 cssn = ROPE[v * 16 + fq * 4 + j];
                const float x1 = acc[m][2 * a][j], x2 = acc[m][2 * a + 1][j];
                acc[m][2 * a][j] = x1 * cssn.x - x2 * cssn.y;
                acc[m][2 * a + 1][j] = x2 * cssn.x + x1 * cssn.y;
              }
            }
          }
        }
      }
      if (col0 >= 1152) {
        bf16_t* VT = (bf16_t*)(P.ws + OFF_VT);
#pragma unroll
        for (int m = 0; m < 4; ++m) {
          const int row = m0 + wr * 64 + m * 16 + fr;
#pragma unroll
          for (int n = 0; n < 4; ++n)
#pragma unroll
            for (int j = 0; j < 4; ++j) VT[(size_t)(col0 - 1152 + n * 16 + fq * 4 + j) * NROW + row] = f2bf(acc[m][n][j]);
        }
      } else {
#pragma unroll
        for (int m = 0; m < 4; ++m) {
          const int row = m0 + wr * 64 + m * 16 + fr;
#pragma unroll
          for (int n = 0; n < 4; ++n) {
            const int col = col0 + n * 16 + fq * 4;
            *(uint2*)(C + (size_t)row * N + col) = make_uint2(pack2(acc[m][n][0], acc[m][n][1]), pack2(acc[m][n][2], acc[m][n][3]));
          }
        }
      }
    } else if (EPI == 1) {
      float* XR = (float*)(P.ws + OFF_XRES);
      const float* MOD = (const float*)(P.ws + OFF_MOD);
      const int mr = m0 < NLAT ? (m0 >> 11) : 8;
      const float* gp = MOD + (size_t)(l * 9 + mr) * 6144 + gidx * 1024 + n0 + wc * 64 + fq * 4;
      float4 gg[4];
#pragma unroll
      for (int n = 0; n < 4; ++n) gg[n] = *(const float4*)(gp + n * 16);
      float* xbase = XR + (size_t)(m0 + wr * 64 + fr) * 1024 + n0 + wc * 64 + fq * 4;
      float4 xv[4][4];
#pragma unroll
      for (int m = 0; m < 4; ++m)
#pragma unroll
        for (int n = 0; n < 4; ++n) xv[m][n] = *(const float4*)(xbase + (size_t)m * 16 * 1024 + n * 16);
      float* obase = final_out ? P.out + (size_t)(m0 + wr * 64 + fr) * 1024 + n0 + wc * 64 + fq * 4 : xbase;
#pragma unroll
      for (int m = 0; m < 4; ++m)
#pragma unroll
        for (int n = 0; n < 4; ++n) {
          float4 o;
          o.x = xv[m][n].x + gg[n].x * acc[m][n][0]; o.y = xv[m][n].y + gg[n].y * acc[m][n][1];
          o.z = xv[m][n].z + gg[n].z * acc[m][n][2]; o.w = xv[m][n].w + gg[n].w * acc[m][n][3];
          *(float4*)(obase + (size_t)m * 16 * 1024 + n * 16) = o;
        }
    } else {
      bf16_t* ACT = (bf16_t*)(P.ws + OFF_ACT);
#pragma unroll
      for (int m = 0; m < 4; ++m) {
        const int row = m0 + wr * 64 + m * 16 + fr;
#pragma unroll
        for (int i = 0; i < 2; ++i) {
          const int col = (n0 >> 1) + wc * 32 + i * 16 + fq * 4;
          float o[4];
#pragma unroll
          for (int j = 0; j < 4; ++j) { const float gt = acc[m][2 * i][j], up = acc[m][2 * i + 1][j]; o[j] = gt * frcp(1.f + __expf(-gt)) * up; }
          *(uint2*)(ACT + (size_t)row * DFF + col) = make_uint2(pack2(o[0], o[1]), pack2(o[2], o[3]));
        }
      }
    }
  }
}

DI void attn_item(const Params& P, int l, int item, char* smem) {
  const int tid = otid(), lane = tid & 63, w = tid >> 6, r = lane & 31, h = lane >> 5;
  bf16_t* sK = (bf16_t*)smem;
  bf16_t* sV = sK + 32 * 72;
  const bf16_t* PROJ = (const bf16_t*)(P.ws + OFF_PROJ);
  bf16_t* CAT = (bf16_t*)(P.ws + OFF_CAT);
  const bool ctxq = item >= 512;
  int b, kvh, qb;
  if (!ctxq) { b = item >> 6; kvh = (item >> 5) & 1; qb = item & 31; }
  else { const int it = item - 512; b = it >> 3; kvh = (it >> 2) & 1; qb = it & 3; }
  const int q0 = qb * 64, head = kvh * 4 + w;
  const int qrow0 = (ctxq ? NLAT + b * 256 : b * 2048) + q0 + r;
  bf16x8 qf[2][4];
#pragma unroll
  for (int u = 0; u < 2; ++u) {
    const bf16_t* qptr = PROJ + (size_t)(qrow0 + 32 * u) * INW + 512 + head * 64 + 8 * h;
#pragma unroll
    for (int s = 0; s < 4; ++s) qf[u][s] = *(const bf16x8*)(qptr + 16 * s);
  }
  int i_lo = 0, nwin = 0;
  if (!ctxq) {
    i_lo = q0 < 128 ? (128 - q0) >> 5 : 0;
    int i_hi = (2144 - q0) >> 5; if (i_hi > 9) i_hi = 9;
    nwin = i_hi - i_lo + 1;
  }
  const int nt = nwin + 8;
  const int key = tid >> 3, t8 = tid & 7;
  const int vd = tid >> 2, vc = tid & 3;
  const bf16_t* VT = (const bf16_t*)(P.ws + OFF_VT) + (size_t)(kvh * 64 + vd) * NROW + vc * 8;
  const float sink2 = P.sink[l * 8 + head] * 1.4426950408889634f;
  float m_run[2] = {sink2, sink2};
  float l_run[2] = {h == 0 ? 1.f : 0.f, h == 0 ? 1.f : 0.f};
  f32x16 oacc[2][2];
#pragma unroll
  for (int i = 0; i < 16; ++i) { oacc[0][0][i] = 0.f; oacc[0][1][i] = 0.f; oacc[1][0][i] = 0.f; oacc[1][1][i] = 0.f; }
  auto tile_row0 = [&](int t) -> size_t {
    const bool kc = t >= nwin;
    const int start = kc ? 32 * (t - nwin) : q0 - 128 + 32 * (i_lo + t);
    return (size_t)((kc ? NLAT + b * 256 : b * 2048) + start);
  };
  auto tile_load = [&](int t, uint4& kr, uint4& vr) {
    if (t < nt) {
      const size_t krow0 = tile_row0(t);
      kr = *(const uint4*)(PROJ + (krow0 + key) * INW + 1024 + kvh * 64 + t8 * 8);
      vr = *(const uint4*)(VT + krow0);
    }
  };
  uint4 kr0, kr1, kr2, kr3, vr0, vr1, vr2, vr3;
  kr0 = kr1 = kr2 = kr3 = vr0 = vr1 = vr2 = vr3 = make_uint4(0u, 0u, 0u, 0u);
  tile_load(0, kr0, vr0); tile_load(1, kr1, vr1); tile_load(2, kr2, vr2); tile_load(3, kr3, vr3);
  constexpr int TILE_E = 32 * 72 + 64 * 40;
  *(uint4*)(sK + key * 72 + t8 * 8) = kr0;
  *(uint4*)(sV + vd * 40 + vc * 8) = vr0;
  tile_load(4, kr0, vr0);
  __syncthreads();
  auto tile_step = [&](int t, uint4& knext, uint4& vnext) {
    const bool kc = t >= nwin;
    const int start = kc ? 32 * (t - nwin) : q0 - 128 + 32 * (i_lo + t);
    if (t + 1 < nt) {
      bf16_t* nb = sK + ((t + 1) & 1) * TILE_E;
      *(uint4*)(nb + key * 72 + t8 * 8) = knext;
      *(uint4*)(nb + 32 * 72 + vd * 40 + vc * 8) = vnext;
      tile_load(t + 5, knext, vnext);
    }
    const bf16_t* sKc = sK + (t & 1) * TILE_E;
    const bf16_t* sVc = sKc + 32 * 72;
    bf16x8 kf[4];
#pragma unroll
    for (int s = 0; s < 4; ++s) kf[s] = *(const bf16x8*)(sKc + r * 72 + 16 * s + 8 * h);
    bf16x8 pf[2][2];
#pragma unroll
    for (int u = 0; u < 2; ++u) {
      f32x16 sacc;
#pragma unroll
      for (int i = 0; i < 16; ++i) sacc[i] = 0.f;
#pragma unroll
      for (int s = 0; s < 4; ++s) sacc = MFMA32(kf[s], qf[u][s], sacc);
      const int q0u = q0 + 32 * u;
      if (!kc && (start < q0u - 97 || start > q0u + 97)) {
#pragma unroll
        for (int i = 0; i < 16; ++i) {
          const int d = start + crow32(i, h) - (q0u + r);
          if (d > 128 || d < -128) sacc[i] = -INFINITY;
        }
      }
      float mx = -INFINITY;
#pragma unroll
      for (int i = 0; i < 16; ++i) mx = fmaxf(mx, sacc[i]);
      mx = fmaxf(mx, __shfl_xor(mx, 32));
      const float m_new = fmaxf(m_run[u], mx);
      const float alpha = __builtin_amdgcn_exp2f(m_run[u] - m_new);
      m_run[u] = m_new;
      float psum = 0.f;
#pragma unroll
      for (int i = 0; i < 16; ++i) { sacc[i] = __builtin_amdgcn_exp2f(sacc[i] - m_new); psum += sacc[i]; }
      l_run[u] = l_run[u] * alpha + psum;
#pragma unroll
      for (int i = 0; i < 16; ++i) { oacc[u][0][i] *= alpha; oacc[u][1][i] *= alpha; }
#pragma unroll
      for (int s2 = 0; s2 < 2; ++s2)
        pf[u][s2] = __builtin_bit_cast(bf16x8, make_uint4(pack2(sacc[8 * s2 + 0], sacc[8 * s2 + 1]), pack2(sacc[8 * s2 + 2], sacc[8 * s2 + 3]),
                                                           pack2(sacc[8 * s2 + 4], sacc[8 * s2 + 5]), pack2(sacc[8 * s2 + 6], sacc[8 * s2 + 7])));
    }
#pragma unroll
    for (int db = 0; db < 2; ++db)
#pragma unroll
      for (int s2 = 0; s2 < 2; ++s2) {
        const bf16_t* vrow = sVc + (32 * db + r) * 40 + 16 * s2 + 4 * h;
        const uint2 lo = *(const uint2*)(vrow), hi = *(const uint2*)(vrow + 8);
        const bf16x8 vf = __builtin_bit_cast(bf16x8, make_uint4(lo.x, lo.y, hi.x, hi.y));
        oacc[0][db] = MFMA32(vf, pf[0][s2], oacc[0][db]);
        oacc[1][db] = MFMA32(vf, pf[1][s2], oacc[1][db]);
      }
    __syncthreads();
  };
  for (int t0 = 0; t0 < nt; t0 += 4) {
    tile_step(t0, kr1, vr1);
    if (t0 + 1 < nt) tile_step(t0 + 1, kr2, vr2);
    if (t0 + 2 < nt) tile_step(t0 + 2, kr3, vr3);
    if (t0 + 3 < nt) tile_step(t0 + 3, kr0, vr0);
  }
#pragma unroll
  for (int u = 0; u < 2; ++u) {
    const float ltot = l_run[u] + __shfl_xor(l_run[u], 32);
    const float inv = frcp(ltot);
    bf16_t* op = CAT + (size_t)(qrow0 + 32 * u) * 1024 + 512 + head * 64;
#pragma unroll
    for (int db = 0; db < 2; ++db)
#pragma unroll
      for (int g4 = 0; g4 < 4; ++g4) {
        const int d = 32 * db + 8 * g4 + 4 * h;
        *(uint2*)(op + d) = make_uint2(pack2(oacc[u][db][4 * g4 + 0] * inv, oacc[u][db][4 * g4 + 1] * inv),
                                       pack2(oacc[u][db][4 * g4 + 2] * inv, oacc[u][db][4 * g4 + 3] * inv));
      }
  }
}

template <int HALF>
DI void pool_diffs(const float (&u)[48], bf16_t* sd, int tid, int t0, int Lseq) {
  float s = 0.f;
#pragma unroll
  for (int i = 8 - HALF; i < 8 + HALF; ++i) s += u[i];
#pragma unroll
  for (int tt = 0; tt < 32; ++tt) {
    if (tt > 0) s += u[8 + tt + HALF - 1] - u[8 + tt - HALF - 1];
    const int t = t0 + tt;
    const int cnt = min(t + HALF, Lseq) - max(t - HALF, 0);
    sd[tt * 264 + tid] = f2bf(s * frcp((float)cnt) - u[8 + tt]);
  }
}

DI void pool_item(const Params& P, int l, int item, char* smem) {
  const int tid = otid();
  bf16_t* sd = (bf16_t*)smem;
  const bf16_t* PROJ = (const bf16_t*)(P.ws + OFF_PROJ);
  bf16_t* CAT = (bf16_t*)(P.ws + OFF_CAT);
  const int row0 = item * 32;
  const int seqstart = row0 < NLAT ? (row0 & ~2047) : NLAT + ((row0 - NLAT) & ~255);
  const int Lseq = row0 < NLAT ? 2048 : 256;
  const int t0 = row0 - seqstart;
  const int gi = __builtin_amdgcn_readfirstlane(tid >> 6);
  {
    float u[48];
#pragma unroll
    for (int i = 0; i < 48; ++i) {
      const int t = t0 - 8 + i;
      const int tc = min(max(t, 0), Lseq - 1);
      const float v = bf2f(PROJ[(size_t)(seqstart + tc) * INW + tid]);
      u[i] = (t >= 0 && t < Lseq) ? v : 0.f;
    }
    if (gi == 0) pool_diffs<1>(u, sd, tid, t0, Lseq);
    else if (gi == 1) pool_diffs<2>(u, sd, tid, t0, Lseq);
    else if (gi == 2) pool_diffs<4>(u, sd, tid, t0, Lseq);
    else pool_diffs<8>(u, sd, tid, t0, Lseq);
  }
  const int lane = tid & 63, fr = lane & 15, fq = lane >> 4;
  const bf16_t* wt = (const bf16_t*)(P.ws + OFF_POOLT) + (size_t)(l * 4 + gi) * 4096 + (size_t)fr * 64 + fq * 8;
  bf16x8 bfr[2][4];
#pragma unroll
  for (int ks = 0; ks < 2; ++ks)
#pragma unroll
    for (int n = 0; n < 4; ++n) bfr[ks][n] = *(const bf16x8*)(wt + n * 16 * 64 + ks * 32);
  float4 sc4[4];
#pragma unroll
  for (int n = 0; n < 4; ++n) sc4[n] = *(const float4*)(P.pool_scale + l * 256 + gi * 64 + n * 16 + fq * 4);
  __syncthreads();
  f32x4 acc[2][4];
#pragma unroll
  for (int m = 0; m < 2; ++m)
#pragma unroll
    for (int n = 0; n < 4; ++n) acc[m][n] = f32x4{0.f, 0.f, 0.f, 0.f};
#pragma unroll
  for (int ks = 0; ks < 2; ++ks) {
    bf16x8 af[2];
#pragma unroll
    for (int m = 0; m < 2; ++m) af[m] = *(const bf16x8*)(sd + (m * 16 + fr) * 264 + gi * 64 + ks * 32 + fq * 8);
#pragma unroll
    for (int m = 0; m < 2; ++m)
#pragma unroll
      for (int n = 0; n < 4; ++n) acc[m][n] = MFMA16(bfr[ks][n], af[m], acc[m][n]);
  }
#pragma unroll
  for (int m = 0; m < 2; ++m)
#pragma unroll
    for (int n = 0; n < 4; ++n)
      *(uint2*)(CAT + (size_t)(row0 + m * 16 + fr) * 1024 + gi * 64 + n * 16 + fq * 4) =
          make_uint2(pack2(acc[m][n][0] * sc4[n].x, acc[m][n][1] * sc4[n].y), pack2(acc[m][n][2] * sc4[n].z, acc[m][n][3] * sc4[n].w));
}

DI int chunk_rowbase(int b, int kap) { return kap < 4 ? NLAT + b * 256 + kap * 64 : b * 2048 + (kap - 4) * 64; }

DI void ssm1_item(const Params& P, int l, int item) {
  const int tid = otid(), lane = tid & 63, w = tid >> 6, n = lane & 15, q = lane >> 4;
  const int g = item / 36, dir = (item / 18) & 1, cb = item % 18;
  const int tb = (l * 16 + g) * 2 + dir;
  const int col = cb * 16 + n, b = col / 36, kap = col % 36;
  const bf16_t* up = (const bf16_t*)(P.ws + OFF_PROJ) + (size_t)chunk_rowbase(b, kap) * INW + 256 + g * 16 + 8 * (q & 1) + (size_t)(q >> 1) * INW;
  const bf16_t* ep = (const bf16_t*)(P.ws + OFF_ETAB) + (size_t)tb * 131072 + (size_t)((2 * w) * 16 + n) * 1024 + 8 * q;
  f32x4 acc0 = {0.f, 0.f, 0.f, 0.f}, acc1 = {0.f, 0.f, 0.f, 0.f};
#pragma unroll 8
  for (int ks = 0; ks < 32; ++ks) {
    const bf16x8 bq = *(const bf16x8*)(up + (size_t)(2 * ks) * INW);
    const bf16x8 a0 = *(const bf16x8*)(ep + ks * 32);
    const bf16x8 a1 = *(const bf16x8*)(ep + 16 * 1024 + ks * 32);
    acc0 = MFMA16(a0, bq, acc0);
    acc1 = MFMA16(a1, bq, acc1);
  }
  float* SL = (float*)(P.ws + OFF_SLOC) + ((size_t)((b * 16 + g) * 2 + dir) * 36 + kap) * 128;
  *(float4*)(SL + (2 * w) * 16 + 4 * q) = make_float4(acc0[0], acc0[1], acc0[2], acc0[3]);
  *(float4*)(SL + (2 * w + 1) * 16 + 4 * q) = make_float4(acc1[0], acc1[1], acc1[2], acc1[3]);
}

DI void ssm3_item(const Params& P, int l, int g, int dir, int cb, int part, char* smem) {
  const int tid = otid(), lane = tid & 63, w = tid >> 6, n = lane & 15, q = lane >> 4;
  const int tb = (l * 16 + g) * 2 + dir;
  bf16_t* sst = (bf16_t*)smem;
  bf16_t* sK = sst + 16 * 128;
  char* sU = (char*)(sK + 64 * 256);
  const bf16_t* PROJ = (const bf16_t*)(P.ws + OFF_PROJ);
  struct U8 { uint4 v0, v1, v2, v3, v4, v5, v6, v7; };
  U8 ureg;
  const int bsel = tid >> 6, sp = tid & 63;
  const int bs_raw = (cb * 16) / 36 + bsel;
  const bool scan_on = tid < 128 && bs_raw <= (cb * 16 + 15) / 36;
  const int bs = scan_on ? bs_raw : (cb * 16) / 36;
  float lr[36], li[36];
  {
    const uint4* src = (const uint4*)((const bf16_t*)(P.ws + OFF_KTAB) + (size_t)tb * 16384) + tid;
    uint4 k0 = src[0], k1 = src[256], k2 = src[512], k3 = src[768], k4 = src[1024], k5 = src[1280], k6 = src[1536], k7 = src[1792];
    const float* SL = (const float*)(P.ws + OFF_SLOC) + (size_t)((bs * 16 + g) * 2 + dir) * 36 * 128 + sp;
#pragma unroll
    for (int step = 0; step < 36; ++step) {
      const int kap = dir == 0 ? step : (step < 4 ? 3 - step : 39 - step);
      lr[step] = SL[kap * 128]; li[step] = SL[kap * 128 + 64];
    }
    auto uload = [&](int i, int hf) {
      const int idx = tid + 256 * i, row = idx >> 1, half = idx & 1, nn = row >> 5, off = (row & 31) + 32 * hf;
      const int colg = cb * 16 + nn;
      return *(const uint4*)(PROJ + (size_t)(chunk_rowbase(colg / 36, colg % 36) + off) * INW + 256 + g * 16 + half * 8);
    };
    ureg.v0 = uload(0, 0); ureg.v1 = uload(1, 0); ureg.v2 = uload(2, 0); ureg.v3 = uload(3, 0);
    ureg.v4 = uload(0, 1); ureg.v5 = uload(1, 1); ureg.v6 = uload(2, 1); ureg.v7 = uload(3, 1);
    uint4* d = (uint4*)sK + tid;
    d[0] = k0; d[256] = k1; d[512] = k2; d[768] = k3; d[1024] = k4; d[1280] = k5; d[1536] = k6; d[1792] = k7;
  }
  if (scan_on) {
    const float2 aT = ((const float2*)(P.ws + OFF_AT))[tb * 64 + sp];
    float sr = 0.f, si = 0.f;
#pragma unroll
    for (int step = 0; step < 36; ++step) {
      const int kap = dir == 0 ? step : (step < 4 ? 3 - step : 39 - step);
      const int nloc = bs * 36 + kap - cb * 16;
      if (nloc >= 0 && nloc < 16) { sst[nloc * 128 + sp] = f2bf(sr); sst[nloc * 128 + 64 + sp] = f2bf(si); }
      const float nr = aT.x * sr - aT.y * si + lr[step], ni = aT.x * si + aT.y * sr + li[step];
      sr = nr; si = ni;
    }
  }
  const bf16_t* FT = (const bf16_t*)(P.ws + OFF_FTAB) + (size_t)tb * 131072 + (size_t)n * 128 + 8 * q;
  float* Y = (float*)(P.ws + OFF_YSSM) + (size_t)(dir * 16 + g) * NROW * 16;
  const bf16x8 zero8 = {0, 0, 0, 0, 0, 0, 0, 0};
  {
    const int colg = cb * 16 + n;
    const bool valid = true;
    const int kapc = n;
    const int rowbase = chunk_rowbase(colg / 36, colg % 36);
    f32x4 acc[16];
#pragma unroll
    for (int oi = 0; oi < 16; ++oi) acc[oi] = f32x4{0.f, 0.f, 0.f, 0.f};
    const char* ub = sU + n * 1056 + (q >> 1) * 32 + (q & 1) * 16;
    const char* kb = (const char*)sK + n * 32 + (q & 1) * 16;
    const int wu = __builtin_amdgcn_readfirstlane(w);
    auto half_body = [&](const int hf, const uint4 u0, const uint4 u1, const uint4 u2, const uint4 u3) {
      __syncthreads();
      {
        const int r0 = tid >> 1, h0 = tid & 1;
        char* d = sU + (r0 >> 5) * 1056 + (r0 & 31) * 32 + h0 * 16;
        *(uint4*)(d) = u0; *(uint4*)(d + 4 * 1056) = u1; *(uint4*)(d + 8 * 1056) = u2; *(uint4*)(d + 12 * 1056) = u3;
      }
      __syncthreads();
#pragma unroll
      for (int G = 0; G < 4; ++G) if (part < 0 || part == G) {
        int ks_lo = dir == 0 ? 0 : ((wu + 16 * G) >> 1);
        int ks_hi = dir == 0 ? ((wu + 16 * G + 12) >> 1) : 31;
        ks_lo = max(ks_lo, 16 * hf);
        ks_hi = min(ks_hi, 16 * hf + 15);
#pragma unroll 2
        for (int ks = ks_lo; ks <= ks_hi; ++ks) {
          const bf16x8 bq = *(const bf16x8*)(ub + (ks - 16 * hf) * 64);
          const int off_in = 2 * ks + (q >> 1);
#pragma unroll
          for (int i = 0; i < 4; ++i) {
            const int off_out = w + 16 * G + 4 * i;
            const int tau = dir == 0 ? off_out - off_in : off_in - off_out;
            const int tc = tau < 0 ? 0 : tau;
            bf16x8 a = *(const bf16x8*)(kb + tc * 512);
            if (tau < 0) a = zero8;
            acc[4 * G + i] = MFMA16(a, bq, acc[4 * G + i]);
          }
        }
      }
    };
    half_body(0, ureg.v0, ureg.v1, ureg.v2, ureg.v3);
    half_body(1, ureg.v4, ureg.v5, ureg.v6, ureg.v7);
    bf16x8 sb[4];
#pragma unroll
    for (int k2 = 0; k2 < 4; ++k2) sb[k2] = *(const bf16x8*)(sst + kapc * 128 + k2 * 32 + 8 * q);
    if (part < 0) {
#pragma unroll
      for (int oh = 0; oh < 2; ++oh) {
        bf16x8 fa[8][4];
#pragma unroll
        for (int o2 = 0; o2 < 8; ++o2)
#pragma unroll
          for (int k2 = 0; k2 < 4; ++k2) fa[o2][k2] = *(const bf16x8*)(FT + (size_t)(w + 4 * (8 * oh + o2)) * 16 * 128 + k2 * 32);
#pragma unroll
        for (int o2 = 0; o2 < 8; ++o2)
#pragma unroll
          for (int k2 = 0; k2 < 4; ++k2) acc[8 * oh + o2] = MFMA16(fa[o2][k2], sb[k2], acc[8 * oh + o2]);
      }
#pragma unroll
      for (int oi = 0; oi < 16; ++oi)
        *(float4*)(Y + (size_t)(rowbase + w + 4 * oi) * 16 + 4 * q) = make_float4(acc[oi][0], acc[oi][1], acc[oi][2], acc[oi][3]);
    } else {
#pragma unroll
      for (int G = 0; G < 4; ++G) if (part == G) {
        bf16x8 fa[4][4];
#pragma unroll
        for (int o2 = 0; o2 < 4; ++o2)
#pragma unroll
          for (int k2 = 0; k2 < 4; ++k2) fa[o2][k2] = *(const bf16x8*)(FT + (size_t)(w + 4 * (4 * G + o2)) * 16 * 128 + k2 * 32);
#pragma unroll
        for (int o2 = 0; o2 < 4; ++o2) {
#pragma unroll
          for (int k2 = 0; k2 < 4; ++k2) acc[4 * G + o2] = MFMA16(fa[o2][k2], sb[k2], acc[4 * G + o2]);
          *(float4*)(Y + (size_t)(rowbase + w + 4 * (4 * G + o2)) * 16 + 4 * q) = make_float4(acc[4 * G + o2][0], acc[4 * G + o2][1], acc[4 * G + o2][2], acc[4 * G + o2][3]);
        }
      }
    }
  }
}

DI void glu_item(const Params& P, int l, int item, char* smem) {
  const int tid = otid(), lane = tid & 63, w = tid >> 6, fr = lane & 15, fq = lane >> 4;
  bf16_t* sG = (bf16_t*)smem;
  const int row0 = item * 64;
  const bf16_t* PROJ = (const bf16_t*)(P.ws + OFF_PROJ);
  const float* Y0 = (const float*)(P.ws + OFF_YSSM);
  const float* Y1 = Y0 + (size_t)NROW * 256;
  bf16_t* CAT = (bf16_t*)(P.ws + OFF_CAT);
#pragma unroll 4
  for (int i = 0; i < 16; ++i) {
    const int rr = tid >> 2, c4 = i * 16 + (tid & 3) * 4;
    const size_t row = (size_t)(row0 + rr);
    const float4 a = *(const float4*)(Y0 + ((size_t)i * NROW + row) * 16 + (tid & 3) * 4), bb = *(const float4*)(Y1 + ((size_t)i * NROW + row) * 16 + (tid & 3) * 4);
    const float4 dd = *(const float4*)(P.ssm_d + l * 256 + c4);
    const uint2 ur = *(const uint2*)(PROJ + row * INW + 256 + c4);
    float y[4] = {dd.x * bflo(ur.x) + a.x + bb.x, dd.y * bfhi(ur.x) + a.y + bb.y, dd.z * bflo(ur.y) + a.z + bb.z, dd.w * bfhi(ur.y) + a.w + bb.w};
#pragma unroll
    for (int j = 0; j < 4; ++j) {
      const float v = y[j];
      const float u = 0.7978845608028654f * (v + 0.044715f * v * v * v);
      const float th = 1.f - 2.f * frcp(1.f + __expf(2.f * u));
      y[j] = 0.5f * v * (1.f + th);
    }
    *(uint2*)(sG + rr * 264 + c4) = make_uint2(pack2(y[0], y[1]), pack2(y[2], y[3]));
  }
  __syncthreads();
  f32x4 acc[4][4];
#pragma unroll
  for (int m = 0; m < 4; ++m)
#pragma unroll
    for (int nn = 0; nn < 4; ++nn) acc[m][nn] = f32x4{0.f, 0.f, 0.f, 0.f};
  const bf16_t* GT = (const bf16_t*)(P.ws + OFF_GLUT) + (size_t)l * 65536 + (size_t)(w * 64 + fr) * 256 + fq * 8;
#pragma unroll 4
  for (int ks = 0; ks < 8; ++ks) {
    bf16x8 af[4], bfr[4];
#pragma unroll
    for (int m = 0; m < 4; ++m) af[m] = *(const bf16x8*)(sG + (m * 16 + fr) * 264 + ks * 32 + fq * 8);
#pragma unroll
    for (int nn = 0; nn < 4; ++nn) bfr[nn] = *(const bf16x8*)(GT + (size_t)nn * 16 * 256 + ks * 32);
#pragma unroll
    for (int m = 0; m < 4; ++m)
#pragma unroll
      for (int nn = 0; nn < 4; ++nn) acc[m][nn] = MFMA16(bfr[nn], af[m], acc[m][nn]);
  }
#pragma unroll
  for (int m = 0; m < 4; ++m) {
    const int rr = m * 16 + fr;
#pragma unroll
    for (int nn = 0; nn < 4; ++nn) {
      const int col = w * 64 + nn * 16 + fq * 4;
      const float4 gb = *(const float4*)(P.glu_b + l * 256 + col);
      const uint2 gr = *(const uint2*)(sG + rr * 264 + col);
      const float z0 = acc[m][nn][0] + gb.x, z1 = acc[m][nn][1] + gb.y, z2 = acc[m][nn][2] + gb.z, z3 = acc[m][nn][3] + gb.w;
      const float o0 = bflo(gr.x) * frcp(1.f + __expf(-z0)), o1 = bfhi(gr.x) * frcp(1.f + __expf(-z1));
      const float o2 = bflo(gr.y) * frcp(1.f + __expf(-z2)), o3 = bfhi(gr.y) * frcp(1.f + __expf(-z3));
      *(uint2*)(CAT + (size_t)(row0 + rr) * 1024 + 256 + col) = make_uint2(pack2(o0, o1), pack2(o2, o3));
    }
  }
}

#define XB_TMO      128
#define XB_XCNT(j)  (256  + 64 * (j))
#define XB_XSUB(j)  (1280 + 64 * (j))
#define XB_XGEN(j)  (2304 + 64 * (j))
#define XB_TOP      3328
#define XB_TOPGEN   3392
#define XCD_BAR_WORDS 3456
#define XB_SPIN_CAP (1u << 21)
#define LAS __attribute__((address_space(3)))

__device__ __forceinline__ unsigned xb_ld(unsigned* p)              { return __hip_atomic_load(p, __ATOMIC_RELAXED, __HIP_MEMORY_SCOPE_AGENT); }
__device__ __forceinline__ unsigned xb_add(unsigned* p, unsigned v) { return __hip_atomic_fetch_add(p, v, __ATOMIC_RELAXED, __HIP_MEMORY_SCOPE_AGENT); }
__device__ __forceinline__ unsigned xb_xcc_id() { return (unsigned)__builtin_amdgcn_s_getreg((3 << 11) | 20) & 0xFu; }
#define XB_SPIN(cond, bar) do { unsigned _sp = 0; while (cond) { __builtin_amdgcn_s_sleep(1); \
    if ((++_sp & 255u) == 0u) { if (xb_ld(&(bar)[XB_TMO])) break; if (_sp > XB_SPIN_CAP) { atomicAdd(&(bar)[XB_TMO], 1u); break; } } } } while (0)

struct XcdBarrier {
    unsigned* bar; unsigned x;
    volatile LAS unsigned* st;
};

__device__ __forceinline__ XcdBarrier xcd_barrier_post(unsigned* bar, volatile LAS unsigned* st) {
    XcdBarrier b; b.bar = bar; b.x = xb_xcc_id(); b.st = st;
    if (threadIdx.x == 0) (void)xb_add(&bar[XB_XCNT(b.x)], 1u);
    return b;
}
__device__ __forceinline__ void xcd_barrier_complete(unsigned* bar, unsigned x, unsigned& nloc, unsigned& nx) {
    const unsigned G = gridDim.x * gridDim.y * gridDim.z;
    unsigned sum, cnt, mine, sp = 0u;
    for (;;) {
        sum = 0u; cnt = 0u; mine = 0u;
#pragma unroll
        for (unsigned j = 0; j < 16; ++j) { const unsigned c = xb_ld(&bar[XB_XCNT(j)]); sum += c; cnt += (c > 0u) ? 1u : 0u; mine = (j == x) ? c : mine; }
        if (sum == G) break;
        __builtin_amdgcn_s_sleep(1);
        if ((++sp & 255u) == 0u) { if (xb_ld(&bar[XB_TMO])) break; if (sp > XB_SPIN_CAP) { atomicAdd(&bar[XB_TMO], 1u); break; } }
    }
    nloc = mine > 0u ? mine : 1u; nx = cnt > 0u ? cnt : 1u;
}

__device__ __forceinline__ void xcd_barrier(const XcdBarrier& b) {
    asm volatile("s_waitcnt vmcnt(0)" ::: "memory");
    __syncthreads();
    if (threadIdx.x == 0) {
        unsigned* bar = b.bar;
        __builtin_amdgcn_s_waitcnt(0);
        unsigned nloc = b.st[0], nx = b.st[1];
        if (nloc == 0u) { xcd_barrier_complete(bar, b.x, nloc, nx); b.st[0] = nloc; b.st[1] = nx; }
        const unsigned old = xb_add(&bar[XB_XSUB(b.x)], 1u);
        const unsigned gen = old / nloc;
        if (old + 1u == (gen + 1u) * nloc) {
            __builtin_amdgcn_fence(__ATOMIC_RELEASE, "agent");
            asm volatile("s_waitcnt vmcnt(0)" ::: "memory");
            const unsigned og = xb_add(&bar[XB_TOP], 1u);
            const unsigned tg = og / nx;
            if (og + 1u == (tg + 1u) * nx) xb_add(&bar[XB_TOPGEN], 1u);
            else XB_SPIN(xb_ld(&bar[XB_TOPGEN]) == tg, bar);
            __builtin_amdgcn_fence(__ATOMIC_ACQUIRE, "agent");
            xb_add(&bar[XB_XGEN(b.x)], 1u);
            asm volatile("s_waitcnt vmcnt(0)" ::: "memory");
        } else {
            XB_SPIN(xb_ld(&bar[XB_XGEN(b.x)]) == gen, bar);
            __builtin_amdgcn_fence(__ATOMIC_ACQUIRE, "agent");
            asm volatile("s_waitcnt vmcnt(0)" ::: "memory");
        }
    }
    __syncthreads();
}


constexpr int NPHASES = 1 + 4 * 9;

template <int SP>
DI void run_sub(const Params& P, int l, char* smem) {
  const bool last = l == 3;
  const int rows_act = last ? NLAT : NROW;
  if constexpr (SP == 9) { ph_prologue(P, smem); }
  else if constexpr (SP == 0) { ph_norm(P, l, 0, NROW); }
  else if constexpr (SP == 1) { ph_gemm<0>(P, l, (const bf16_t*)(P.ws + OFF_H), (const bf16_t*)(P.ws + OFF_WIN) + l * W_IN_E, NROW, INW, DM, 0, false, smem); }
  else if constexpr (SP == 2) {
    const int nattn = last ? 512 : 576;
    const int total = nattn + 576;
    for (int it = blockIdx.x; it < total; it += gridDim.x) {
      if (it < nattn) attn_item(P, l, it, smem);
      else ssm1_item(P, l, it - nattn);
      __syncthreads();
    }
  }
  else if constexpr (SP == 3) {
    const int npool = rows_act / 32;
    for (int it = blockIdx.x; it < 768 + npool; it += gridDim.x) {
      if (it < 512) ssm3_item(P, l, it >> 5, (it >> 4) & 1, it & 15, -1, smem);
      else if (it < 768) { const int j = it - 512; ssm3_item(P, l, j >> 4, (j >> 3) & 1, 16 + ((j >> 2) & 1), j & 3, smem); }
      else pool_item(P, l, it - 768, smem);
      __syncthreads();
    }
  }
  else if constexpr (SP == 4) { for (int it = blockIdx.x; it < rows_act / 64; it += gridDim.x) { glu_item(P, l, it, smem); __syncthreads(); } }
  else if constexpr (SP == 5) { ph_gemm<1>(P, l, (const bf16_t*)(P.ws + OFF_CAT), (const bf16_t*)(P.ws + OFF_WOUT) + l * W_OUT_E, rows_act, DM, DM, 2, false, smem); }
  else if constexpr (SP == 6) { ph_norm(P, l, 1, rows_act); }
  else if constexpr (SP == 7) { ph_gemm<2>(P, l, (const bf16_t*)(P.ws + OFF_H), (const bf16_t*)(P.ws + OFF_WGU) + l * W_GU_E, rows_act, 2 * DFF, DM, 0, false, smem); }
  else if constexpr (SP == 8) { ph_gemm<1>(P, l, (const bf16_t*)(P.ws + OFF_ACT), (const bf16_t*)(P.ws + OFF_WD) + l * W_D_E, rows_act, DM, DFF, 5, last, smem); }
}

DI void run_phase(const Params& P, int ph, char* smem) {
  if (ph == 0) { run_sub<9>(P, 0, smem); return; }
  const int l = (ph - 1) / 9, sp = (ph - 1) % 9;
  switch (sp) {
    case 0: run_sub<0>(P, l, smem); break;
    case 1: run_sub<1>(P, l, smem); break;
    case 2: run_sub<2>(P, l, smem); break;
    case 3: run_sub<3>(P, l, smem); break;
    case 4: run_sub<4>(P, l, smem); break;
    case 5: run_sub<5>(P, l, smem); break;
    case 6: run_sub<6>(P, l, smem); break;
    case 7: run_sub<7>(P, l, smem); break;
    case 8: run_sub<8>(P, l, smem); break;
  }
}

extern __shared__ __attribute__((aligned(16))) char dyn_smem[];

#if !MEGA
template <int SP> __global__ void __launch_bounds__(NTHREADS, 2) k_sub(Params P, int l) { run_sub<SP>(P, l, dyn_smem); }
#endif

#if MEGA
__global__ void __launch_bounds__(NTHREADS, 2) k_mega(Params P) {
  cg::grid_group grid = cg::this_grid();
  uint4* xbw = (uint4*)(dyn_smem + LDS_PHASE);
  if (threadIdx.x == 0) *xbw = make_uint4(0u, 0u, 0u, 0u);
  __syncthreads();
  XcdBarrier xb = xcd_barrier_post((unsigned*)(P.ws + OFF_BAR), (volatile LAS unsigned*)xbw);
  run_sub<9>(P, 0, dyn_smem);
  if (P.ws == nullptr) grid.sync();
  xcd_barrier(xb);
#pragma unroll 1
  for (int l = 0; l < 4; ++l) {
    run_sub<0>(P, l, dyn_smem); xcd_barrier(xb);
    run_sub<1>(P, l, dyn_smem); xcd_barrier(xb);
    run_sub<2>(P, l, dyn_smem); xcd_barrier(xb);
    run_sub<3>(P, l, dyn_smem); xcd_barrier(xb);
    run_sub<4>(P, l, dyn_smem); xcd_barrier(xb);
    run_sub<5>(P, l, dyn_smem); xcd_barrier(xb);
    run_sub<6>(P, l, dyn_smem); xcd_barrier(xb);
    run_sub<7>(P, l, dyn_smem); xcd_barrier(xb);
    run_sub<8>(P, l, dyn_smem);
    if (l < 3) xcd_barrier(xb);
  }
}
#define OCC_KERNEL k_mega
#else
#define OCC_KERNEL k_sub<1>
#endif

extern "C" void kernel_launch(void* const* d_in, const int* in_sizes, int n_in, void* d_out, int out_size, void* d_ws, size_t ws_size,
                              hipStream_t stream) {
  if (n_in < 28 || ws_size < WS_END) { fprintf(stderr, "kernel_launch: bad inputs (n_in %d, ws %zu < %zu)\n", n_in, ws_size, (size_t)WS_END); return; }
  Params P{};
  const float** pp = (const float**)&P;
  for (int i = 0; i < 28; ++i) pp[i] = (const float*)d_in[i];
  P.out = (float*)d_out;
  P.ws = (char*)d_ws;
  static int grid_blocks = 0;
  if (!grid_blocks) {
    int dev = 0, cus = 0, per_cu = 0;
    hipGetDevice(&dev);
    hipDeviceGetAttribute(&cus, hipDeviceAttributeMultiprocessorCount, dev);
#if MEGA
    hipFuncSetAttribute((const void*)k_mega, hipFuncAttributeMaxDynamicSharedMemorySize, LDS_BYTES);
#endif
#if !MEGA
    hipFuncSetAttribute((const void*)k_sub<0>, hipFuncAttributeMaxDynamicSharedMemorySize, LDS_BYTES);
    hipFuncSetAttribute((const void*)k_sub<1>, hipFuncAttributeMaxDynamicSharedMemorySize, LDS_BYTES);
    hipFuncSetAttribute((const void*)k_sub<2>, hipFuncAttributeMaxDynamicSharedMemorySize, LDS_BYTES);
    hipFuncSetAttribute((const void*)k_sub<3>, hipFuncAttributeMaxDynamicSharedMemorySize, LDS_BYTES);
    hipFuncSetAttribute((const void*)k_sub<4>, hipFuncAttributeMaxDynamicSharedMemorySize, LDS_BYTES);
    hipFuncSetAttribute((const void*)k_sub<5>, hipFuncAttributeMaxDynamicSharedMemorySize, LDS_BYTES);
    hipFuncSetAttribute((const void*)k_sub<6>, hipFuncAttributeMaxDynamicSharedMemorySize, LDS_BYTES);
    hipFuncSetAttribute((const void*)k_sub<7>, hipFuncAttributeMaxDynamicSharedMemorySize, LDS_BYTES);
    hipFuncSetAttribute((const void*)k_sub<8>, hipFuncAttributeMaxDynamicSharedMemorySize, LDS_BYTES);
    hipFuncSetAttribute((const void*)k_sub<9>, hipFuncAttributeMaxDynamicSharedMemorySize, LDS_BYTES);
#endif
    hipOccupancyMaxActiveBlocksPerMultiprocessor(&per_cu, (const void*)OCC_KERNEL, NTHREADS, LDS_BYTES);
    if (per_cu < 1) per_cu = 1;
    if (per_cu > 2) per_cu = 2;
    grid_blocks = cus * per_cu;
  }
#if MEGA
  hipMemsetAsync((char*)d_ws + OFF_BAR, 0, BAR_BYTES, stream);
  void* args[] = {&P};
  hipError_t e = hipLaunchCooperativeKernel((const void*)k_mega, dim3(grid_blocks), dim3(NTHREADS), args, LDS_BYTES, stream);
  if (e != hipSuccess) fprintf(stderr, "cooperative launch failed: %s (grid %d)\n", hipGetErrorString(e), grid_blocks);
#else
  const dim3 G(grid_blocks), T(NTHREADS);
  k_sub<9><<<G, T, LDS_BYTES, stream>>>(P, 0);
  for (int l = 0; l < 4; ++l) {
    k_sub<0><<<G, T, LDS_BYTES, stream>>>(P, l);
    k_sub<1><<<G, T, LDS_BYTES, stream>>>(P, l);
    k_sub<2><<<G, T, LDS_BYTES, stream>>>(P, l);
    k_sub<3><<<G, T, LDS_BYTES, stream>>>(P, l);
    k_sub<4><<<G, T, LDS_BYTES, stream>>>(P, l);
    k_sub<5><<<G, T, LDS_BYTES, stream>>>(P, l);
    k_sub<6><<<G, T, LDS_BYTES, stream>>>(P, l);
    k_sub<7><<<G, T, LDS_BYTES, stream>>>(P, l);
    k_sub<8><<<G, T, LDS_BYTES, stream>>>(P, l);
  }
#endif
}
```
